# Optimizing an MI355X kernel written in HIP

```python
import math, functools
import jax, jax.numpy as jnp
from jax import lax
import numpy as np

D_MODEL = 2048
BATCH = 32
SEQ = 256
DEPTH = 2
DEC_BATCH = 2
DEC_SEQ = 1024
PAST_LEN = 512

GRID_W = 64
MIX_W = D_MODEL
ATT_W = MIX_W // 2
LRU_W = MIX_W // 4
HY_W = MIX_W // 4
HEAD_DIM = 64
N_HEADS = ATT_W // (2 * HEAD_DIM)
LRU_BLOCKS = 8
LRU_BW = LRU_W // LRU_BLOCKS
LRU_C = 8.0
LRU_CONV = 4
HY_CONV = 3
HY_BANDS = 16
HY_POS = 1 + 2 * HY_BANDS
HY_HIDDEN = 64
HY_DECAY_FAST = 0.3
HY_DECAY_SLOW = 1.5
HY_DECAY_TARGET = 1e-2
ROPE_BASE = 10000.0
Q_BLOCK = 128
EPS = 1e-6
IN_W = 4 * ATT_W + 2 * LRU_W + 4 * HY_W
SPLITS = [ATT_W, 2 * ATT_W, 3 * ATT_W, 4 * ATT_W, 4 * ATT_W + LRU_W, 4 * ATT_W + 2 * LRU_W, 4 * ATT_W + 2 * LRU_W + HY_W, 4 * ATT_W + 2 * LRU_W + 2 * HY_W, 4 * ATT_W + 2 * LRU_W + 3 * HY_W]

kernel_name = 'hymba_diffattn_rglru_hyena_diffusion_step'


def rmsnorm(x, g):
    xf = x.astype(jnp.float32)
    xf = xf * lax.rsqrt(jnp.mean(xf * xf, axis=-1, keepdims=True) + EPS)
    return (xf * g.astype(jnp.float32)).astype(x.dtype)


def dwconv(x, w, b, left, right):
    L = x.shape[1]
    xp = jnp.pad(x, ((0, 0), (left, right), (0, 0)))
    out = xp[:, 0:L] * w[0]
    for t in range(1, w.shape[0]):
        out = out + xp[:, t:t + L] * w[t]
    return out + b


def axial_rope(n_tok):
    rows = n_tok // GRID_W
    r, col = jnp.meshgrid(jnp.arange(rows, dtype=jnp.float32), jnp.arange(GRID_W, dtype=jnp.float32), indexing='ij')
    r = r.reshape(-1)
    col = col.reshape(-1)
    nf = HEAD_DIM // 4
    inv = ROPE_BASE ** (-jnp.arange(nf, dtype=jnp.float32) / nf)
    ang = jnp.stack([r[:, None] * inv, col[:, None] * inv], axis=1)
    return jnp.cos(ang), jnp.sin(ang)


def apply_axial_rope(x, cos, sin):
    nf = HEAD_DIM // 4
    xr = x.reshape(x.shape[:-1] + (2, HEAD_DIM // 2))
    a, b = xr[..., :nf], xr[..., nf:]
    cs = cos[None, :, None, None]
    sn = sin[None, :, None, None]
    out = jnp.concatenate([a * cs - b * sn, b * cs + a * sn], axis=-1)
    return out.reshape(x.shape).astype(x.dtype)


def diff_attention(q, k, v, lam):
    B, Lq = q.shape[0], q.shape[1]
    nblk = Lq // Q_BLOCK
    qb = jnp.moveaxis(q.reshape(B, nblk, Q_BLOCK, N_HEADS, 2, HEAD_DIM), 1, 0)
    scale = HEAD_DIM ** -0.5

    def block(qblk):
        s = jnp.einsum('bqhcd,bkhcd->bchqk', qblk, k, preferred_element_type=jnp.float32) * scale
        p = jax.nn.softmax(s, axis=-1)
        w = p[:, 0] - lam * p[:, 1]
        return jnp.einsum('bhqk,bkhe->bqhe', w.astype(v.dtype), v)

    out = lax.map(block, qb)
    return jnp.moveaxis(out, 0, 1).reshape(B, Lq, N_HEADS, 2 * HEAD_DIM)


def _combine(left, right):
    a_l, b_l = left
    a_r, b_r = right
    return a_l * a_r, a_r * b_l + b_r


def rglru_dir(xc, wa, ba, wi, bi, lam, h0, reverse):
    B, L, W = xc.shape
    xb = xc.reshape(B, L, LRU_BLOCKS, LRU_BW)
    r = jax.nn.sigmoid(jnp.einsum('blnc,ncd->blnd', xb, wa.astype(jnp.float32)).reshape(B, L, W) + ba.astype(jnp.float32))
    i = jax.nn.sigmoid(jnp.einsum('blnc,ncd->blnd', xb, wi.astype(jnp.float32)).reshape(B, L, W) + bi.astype(jnp.float32))
    log_a = -LRU_C * r * jax.nn.softplus(-lam.astype(jnp.float32))
    a = jnp.exp(log_a)
    b = jnp.sqrt(-jnp.expm1(2.0 * log_a)) * (i * xc)
    if reverse:
        a = jnp.flip(a, axis=1)
        b = jnp.flip(b, axis=1)
    b = b.at[:, 0].add(a[:, 0] * h0.astype(jnp.float32))
    _, h = lax.associative_scan(_combine, (a, b), axis=1)
    if reverse:
        h = jnp.flip(h, axis=1)
    return h


def hyena_filters(L, w1, b1, w2, b2, w3):
    pos = jnp.arange(L, dtype=jnp.float32)
    t = pos / float(max(L - 1, 1))
    bands = jnp.linspace(1e-4, HY_BANDS - 1, HY_BANDS, dtype=jnp.float32)
    ang = (2.0 * math.pi / L) * pos[:, None] * bands[None, :]
    z = jnp.concatenate([t[:, None], jnp.cos(ang), jnp.sin(ang)], axis=-1)
    hdn = jnp.sin(jnp.matmul(z, w1.astype(jnp.float32)) + b1.astype(jnp.float32))
    hdn = jnp.sin(jnp.matmul(hdn, w2.astype(jnp.float32)) + b2.astype(jnp.float32))
    filt = jnp.matmul(hdn, w3.astype(jnp.float32)).reshape(L, 2, HY_W)
    lo = abs(math.log(HY_DECAY_TARGET) / HY_DECAY_SLOW)
    hi = abs(math.log(HY_DECAY_TARGET) / HY_DECAY_FAST)
    deltas = jnp.linspace(lo, hi, HY_W, dtype=jnp.float32)
    decay = jnp.exp(-t[:, None] * deltas[None, :])
    filt = filt * decay[:, None, :]
    return filt[:, 0], filt[:, 1]


def bidir_long_conv(u, hf, hb, d):
    L, C = u.shape[1], u.shape[2]
    n = 2 * L
    g = jnp.concatenate([hf, jnp.zeros((1, C), jnp.float32), jnp.flip(hb[1:], axis=0)], axis=0)
    uf = u.astype(jnp.float32)
    y = jnp.fft.irfft(jnp.fft.rfft(uf, n=n, axis=1) * jnp.fft.rfft(g, n=n, axis=0)[None], n=n, axis=1)[:, :L]
    return (y + uf * d.astype(jnp.float32)).astype(u.dtype)


def run_layer(x, cond, rope, ctx_k, ctx_v, h0, lam, lam_init, norm_g, w_ada, b_ada, w_in, w_out, subln_g, lru_conv_w, lru_conv_b, lru_wa, lru_ba, lru_wi, lru_bi, lru_lam, hy_conv_w, hy_conv_b, hy_w1, hy_b1, hy_w2, hy_b2, hy_w3, hy_d):
    B, L, _ = x.shape
    mod = jnp.matmul(jax.nn.silu(cond), w_ada) + b_ada
    shift, scale, gate = jnp.split(mod[:, None, :], 3, axis=-1)
    h = rmsnorm(x, norm_g) * (1 + scale) + shift
    proj = jnp.matmul(h, w_in)
    q, k, v, ag, lx, lg, hv, hx1, hx0, hg = jnp.split(proj, SPLITS, axis=-1)

    q = q.reshape(B, L, N_HEADS, 2, HEAD_DIM)
    k = k.reshape(B, L, N_HEADS, 2, HEAD_DIM)
    v = v.reshape(B, L, N_HEADS, 2 * HEAD_DIM)
    k_store = k.reshape(B, L, N_HEADS, 2 * HEAD_DIM)
    v_store = v
    if rope is not None:
        q = apply_axial_rope(q, rope[0], rope[1])
        k = apply_axial_rope(k, rope[0], rope[1])
    if ctx_k is not None:
        P = ctx_k.shape[1]
        k = jnp.concatenate([ctx_k.reshape(B, P, N_HEADS, 2, HEAD_DIM).astype(k.dtype), k], axis=1)
        v = jnp.concatenate([ctx_v.astype(v.dtype), v], axis=1)
    att = diff_attention(q, k, v, lam)
    att = rmsnorm(att, subln_g) * (1.0 - lam_init)
    att = att.reshape(B, L, ATT_W) * jax.nn.silu(ag)

    xc = dwconv(lx, lru_conv_w, lru_conv_b, 2, 1).astype(jnp.float32)
    if h0 is None:
        h0 = jnp.zeros((B, 2, LRU_W), jnp.float32)
    h_f = rglru_dir(xc, lru_wa[0], lru_ba[0], lru_wi[0], lru_bi[0], lru_lam[0], h0[:, 0], False)
    h_b = rglru_dir(xc, lru_wa[1], lru_ba[1], lru_wi[1], lru_bi[1], lru_lam[1], h0[:, 1], True)
    h_last = jnp.stack([h_f[:, -1], h_b[:, 0]], axis=1)
    lru = (h_f + h_b).astype(x.dtype) * jax.nn.silu(lg)

    u = dwconv(jnp.concatenate([hv, hx1, hx0], axis=-1), hy_conv_w, hy_conv_b, 1, 1)
    hv, hx1, hx0 = jnp.split(u, 3, axis=-1)
    filt_f, filt_b = hyena_filters(L, hy_w1, hy_b1, hy_w2, hy_b2, hy_w3)
    hy = hx0 * bidir_long_conv(hx1 * hv, filt_f, filt_b, hy_d)
    hy = hy * jax.nn.silu(hg)

    out = jnp.matmul(jnp.concatenate([att, lru, hy], axis=-1), w_out)
    return x + gate * out, k_store, v_store, h_last


def setup_inputs(seed: int = 0) -> dict:
    key = jax.random.key(seed)
    ks = jax.random.split(key, 40)

    def nrm(k, shape, s):
        return s * jax.random.normal(k, shape, jnp.float32)

    u = jax.random.uniform(ks[23], (DEPTH, 2, LRU_W), jnp.float32, 0.9, 0.999)
    a = u ** (1.0 / LRU_C)
    return {
        'x_prompt': nrm(ks[0], (BATCH, SEQ, D_MODEL), 1.0),
        'x_sample': nrm(ks[1], (DEC_BATCH, DEC_SEQ, D_MODEL), 1.0),
        'cache_k': nrm(ks[2], (DEC_BATCH, DEPTH, PAST_LEN, N_HEADS, 2 * HEAD_DIM), 1.0),
        'cache_v': nrm(ks[3], (DEC_BATCH, DEPTH, PAST_LEN, N_HEADS, 2 * HEAD_DIM), 1.0),
        'state_lru': nrm(ks[4], (DEC_BATCH, DEPTH, 2, LRU_W), 0.5),
        'c': nrm(ks[5], (DEC_BATCH, D_MODEL), 1.0),
        'c_ctx': nrm(ks[6], (D_MODEL,), 1.0),
        'norm_g': 1.0 + nrm(ks[7], (DEPTH, D_MODEL), 0.02),
        'w_ada': nrm(ks[8], (DEPTH, D_MODEL, 3 * D_MODEL), 0.5 * D_MODEL ** -0.5),
        'b_ada': nrm(ks[9], (DEPTH, 3 * D_MODEL), 0.02),
        'w_in': nrm(ks[10], (DEPTH, D_MODEL, IN_W), D_MODEL ** -0.5),
        'w_out': nrm(ks[11], (DEPTH, MIX_W, D_MODEL), MIX_W ** -0.5),
        'lam_q1': nrm(ks[12], (DEPTH, HEAD_DIM), 0.1),
        'lam_k1': nrm(ks[13], (DEPTH, HEAD_DIM), 0.1),
        'lam_q2': nrm(ks[14], (DEPTH, HEAD_DIM), 0.1),
        'lam_k2': nrm(ks[15], (DEPTH, HEAD_DIM), 0.1),
        'attn_subln_g': 1.0 + nrm(ks[16], (DEPTH, 2 * HEAD_DIM), 0.02),
        'lru_conv_w': nrm(ks[17], (DEPTH, LRU_CONV, LRU_W), LRU_CONV ** -0.5),
        'lru_conv_b': nrm(ks[18], (DEPTH, LRU_W), 0.02),
        'lru_wa': nrm(ks[19], (DEPTH, 2, LRU_BLOCKS, LRU_BW, LRU_BW), LRU_BW ** -0.5),
        'lru_ba': nrm(ks[20], (DEPTH, 2, LRU_W), 0.02),
        'lru_wi': nrm(ks[21], (DEPTH, 2, LRU_BLOCKS, LRU_BW, LRU_BW), LRU_BW ** -0.5),
        'lru_bi': nrm(ks[22], (DEPTH, 2, LRU_W), 0.02),
        'lru_lam': jnp.log(a) - jnp.log1p(-a),
        'hy_conv_w': nrm(ks[24], (DEPTH, HY_CONV, 3 * HY_W), HY_CONV ** -0.5),
        'hy_conv_b': nrm(ks[25], (DEPTH, 3 * HY_W), 0.02),
        'hy_w1': nrm(ks[26], (DEPTH, HY_POS, HY_HIDDEN), HY_POS ** -0.5),
        'hy_b1': nrm(ks[27], (DEPTH, HY_HIDDEN), 0.1),
        'hy_w2': nrm(ks[28], (DEPTH, HY_HIDDEN, HY_HIDDEN), HY_HIDDEN ** -0.5),
        'hy_b2': nrm(ks[29], (DEPTH, HY_HIDDEN), 0.1),
        'hy_w3': nrm(ks[30], (DEPTH, HY_HIDDEN, 2 * HY_W), 0.05 * HY_HIDDEN ** -0.5),
        'hy_d': nrm(ks[31], (DEPTH, HY_W), 0.5),
        'final_g': 1.0 + nrm(ks[32], (D_MODEL,), 0.02),
    }


def reference(x_prompt, x_sample, cache_k, cache_v, state_lru, c, c_ctx, norm_g, w_ada, b_ada, w_in, w_out, lam_q1, lam_k1, lam_q2, lam_k2, attn_subln_g, lru_conv_w, lru_conv_b, lru_wa, lru_ba, lru_wi, lru_bi, lru_lam, hy_conv_w, hy_conv_b, hy_w1, hy_b1, hy_w2, hy_b2, hy_w3, hy_d, final_g):
    rope = axial_rope(x_sample.shape[1])
    ctx_cond = c_ctx[None, :]
    xp, xs = x_prompt, x_sample
    ks, vs, hs = [], [], []
    for l in range(DEPTH):
        lam_init = 0.8 - 0.6 * math.exp(-0.3 * l)
        lam = (jnp.exp(jnp.sum(lam_q1[l].astype(jnp.float32) * lam_k1[l].astype(jnp.float32)))
               - jnp.exp(jnp.sum(lam_q2[l].astype(jnp.float32) * lam_k2[l].astype(jnp.float32))) + lam_init)
        layer = functools.partial(
            run_layer, lam=lam, lam_init=lam_init, norm_g=norm_g[l], w_ada=w_ada[l], b_ada=b_ada[l],
            w_in=w_in[l], w_out=w_out[l], subln_g=attn_subln_g[l], lru_conv_w=lru_conv_w[l],
            lru_conv_b=lru_conv_b[l], lru_wa=lru_wa[l], lru_ba=lru_ba[l], lru_wi=lru_wi[l],
            lru_bi=lru_bi[l], lru_lam=lru_lam[l], hy_conv_w=hy_conv_w[l], hy_conv_b=hy_conv_b[l],
            hy_w1=hy_w1[l], hy_b1=hy_b1[l], hy_w2=hy_w2[l], hy_b2=hy_b2[l], hy_w3=hy_w3[l], hy_d=hy_d[l])
        xp, k_l, v_l, h_l = layer(xp, ctx_cond, None, None, None, None)
        ks.append(k_l)
        vs.append(v_l)
        hs.append(h_l)
        xs, _, _, _ = layer(xs, c, rope, cache_k[:, l], cache_v[:, l], state_lru[:, l])
    y_prompt = rmsnorm(xp, final_g)
    y_sample = rmsnorm(xs, final_g)
    new_cache_k = jnp.stack(ks, axis=1)
    new_cache_v = jnp.stack(vs, axis=1)
    new_state_lru = jnp.stack(hs, axis=1)
    return (y_prompt, y_sample, new_cache_k, new_cache_v, new_state_lru)
```

```cpp
#include <hip/hip_runtime.h>
#include <hip/hip_cooperative_groups.h>
#include <cstdint>
#include <cstdio>
namespace cg = cooperative_groups;

#define DEVI __device__ __forceinline__
typedef unsigned short bf16_t;
using bf16x8 = __attribute__((ext_vector_type(8))) short;
using f32x4 = __attribute__((ext_vector_type(4))) float;

constexpr int D = 2048, NB = 32, SEQ = 256, DEPTH = 2, DB = 2, DSEQ = 1024, PAST = 512;
constexpr int NH = 8, IN_W = 7168;
constexpr int MC = NB * SEQ, MS = DB * DSEQ, MT = MC + MS;
constexpr int CQ = 0, CK = 1024, CV = 2048, CAG = 3072, CLX = 4096, CLG = 4608, CHV = 5120, CHX1 = 5632, CHX0 = 6144, CHG = 6656;
constexpr int NT = 512;

constexpr size_t OUT_YP = 0, OUT_YS = (size_t)MC * D, OUT_K = (size_t)MT * D, OUT_V = OUT_K + (size_t)NB * DEPTH * SEQ * 1024,
                 OUT_ST = OUT_V + (size_t)NB * DEPTH * SEQ * 1024;

constexpr size_t WS_CTL = 0;
constexpr size_t WS_MOD = 65536;
constexpr size_t MOD_BYTES = (size_t)2 * 3 * 6144 * 4;
constexpr size_t WS_ROPE = WS_MOD + MOD_BYTES;
constexpr size_t WS_FILT = WS_ROPE + 2 * 1024 * 32 * 4;
constexpr size_t FILT_PER_LAYER = (size_t)2 * 256 * 512 + (size_t)2 * 1024 * 512;
constexpr size_t WS_WINT = WS_FILT + 2 * FILT_PER_LAYER * 4;
constexpr size_t WS_WOUTT = WS_WINT + (size_t)2 * IN_W * D * 2;
constexpr size_t WS_H = WS_WOUTT + (size_t)2 * D * D * 2;
constexpr size_t WS_P = WS_H + (size_t)MT * D * 2;
constexpr size_t WS_MIX = WS_P + (size_t)MT * IN_W * 2;
constexpr size_t WS_SCR = WS_MIX + (size_t)MT * D * 2;
constexpr size_t SCR1 = (size_t)MT * 512 * 4;
constexpr size_t WS_XC = WS_SCR, WS_AF = WS_XC + SCR1, WS_BF = WS_AF + SCR1, WS_AB = WS_BF + SCR1, WS_BB = WS_AB + SCR1, WS_HS = WS_BB + SCR1;
constexpr size_t WS_END = WS_HS + SCR1;
constexpr size_t WS_HYV = WS_H, WS_HX0C = WS_H + SCR1;

struct Params {
    const float *x_prompt, *x_sample, *cache_k, *cache_v, *state_lru, *c, *c_ctx, *norm_g, *w_ada, *b_ada, *w_in, *w_out,
        *lam_q1, *lam_k1, *lam_q2, *lam_k2, *subln_g, *lru_conv_w, *lru_conv_b, *lru_wa, *lru_ba, *lru_wi, *lru_bi, *lru_lam,
        *hy_conv_w, *hy_conv_b, *hy_w1, *hy_b1, *hy_w2, *hy_b2, *hy_w3, *hy_d, *final_g;
    float* out; unsigned char* ws;
};

DEVI bf16_t f2bf(float f) { unsigned u = __float_as_uint(f); u += 0x7fffu + ((u >> 16) & 1u); return (bf16_t)(u >> 16); }
DEVI float bf2f(bf16_t h) { return __uint_as_float(((unsigned)h) << 16); }
DEVI float silu_f(float x) { return x / (1.f + expf(-x)); }
DEVI float sigmoid_f(float x) { return 1.f / (1.f + expf(-x)); }
DEVI float wave_sum(float v) { for (int o = 32; o > 0; o >>= 1) v += __shfl_xor(v, o); return v; }
DEVI float wave_max(float v) { for (int o = 32; o > 0; o >>= 1) v = fmaxf(v, __shfl_xor(v, o)); return v; }
DEVI int cond_of_row(int row) { return row < MC ? 0 : 1 + (row - MC) / DSEQ; }
DEVI float lam_init_of(int l) { return l == 0 ? 0.2f : (0.8f - 0.6f * 0.74081822068171786607f); }

DEVI void transpose_item(const float* W, int N, bf16_t* WT, int item, float* tile  ) {
    const int nN = N / 64, k0 = (item / nN) * 64, n0 = (item % nN) * 64, t = threadIdx.x;
#pragma unroll
    for (int i = 0; i < 8; ++i) { const int n = t & 63, kk = (t >> 6) + 8 * i; tile[kk * 65 + n] = W[(size_t)(k0 + kk) * N + n0 + n]; }
    __syncthreads();
#pragma unroll
    for (int i = 0; i < 8; ++i) { const int k = t & 63, nn = (t >> 6) + 8 * i; WT[(size_t)(n0 + nn) * D + k0 + k] = f2bf(tile[k * 65 + nn]); }
    __syncthreads();
}
DEVI void mods_item(const Params& p, int item, float* sc  ) {
    const int l = item / (16 * 12), kc = (item / 12) % 16, nb = item % 12, t = threadIdx.x;
    float* MOD = (float*)(p.ws + WS_MOD);
    if (t < 384) { const int j = t / 128, kk = t % 128, k = kc * 128 + kk; const float cv = (j == 0) ? p.c_ctx[k] : p.c[(j - 1) * D + k]; sc[j * 128 + kk] = silu_f(cv); }
    __syncthreads();
    const int n = nb * 512 + t; float a0 = 0.f, a1 = 0.f, a2 = 0.f;
    const float* w = p.w_ada + ((size_t)l * D + kc * 128) * 6144 + n;
#pragma unroll 8
    for (int kk = 0; kk < 128; ++kk) { const float wv = w[(size_t)kk * 6144]; a0 += sc[kk] * wv; a1 += sc[128 + kk] * wv; a2 += sc[256 + kk] * wv; }
    const float bv = (kc == 0) ? p.b_ada[l * 6144 + n] : 0.f;
    atomicAdd(&MOD[(l * 3 + 0) * 6144 + n], a0 + bv); atomicAdd(&MOD[(l * 3 + 1) * 6144 + n], a1 + bv); atomicAdd(&MOD[(l * 3 + 2) * 6144 + n], a2 + bv);
    __syncthreads();
}
DEVI void filter_item(const Params& p, int item, float* sm  ) {
    const int l = item / 1280, r = item % 1280, Lsel = r >= 256, pos = Lsel ? r - 256 : r, L = Lsel ? 1024 : 256, t = threadIdx.x;
    float* z = sm; float* h1 = sm + 64; float* h2 = sm + 128;
    const float tt = (float)pos / (float)(L - 1);
    if (t < 33) {
        float v;
        if (t == 0) v = tt;
        else { const int i = (t - 1) & 15; const float band = 1e-4f + (float)i * ((15.0f - 1e-4f) / 15.0f); const float ang = (6.283185307179586f / (float)L) * (float)pos * band; v = (t <= 16) ? cosf(ang) : sinf(ang); }
        z[t] = v;
    }
    __syncthreads();
    if (t < 64) { float a = p.hy_b1[l * 64 + t]; for (int i = 0; i < 33; ++i) a += z[i] * p.hy_w1[(l * 33 + i) * 64 + t]; h1[t] = sinf(a); }
    __syncthreads();
    if (t < 64) { float a = p.hy_b2[l * 64 + t]; for (int i = 0; i < 64; ++i) a += h1[i] * p.hy_w2[(l * 64 + i) * 64 + t]; h2[t] = sinf(a); }
    __syncthreads();
    float* F = (float*)(p.ws + WS_FILT) + (size_t)l * FILT_PER_LAYER + (Lsel ? (size_t)2 * 256 * 512 : 0);
    const float lo = 3.0701134573253945f, hi = 15.350567286626973f;
    const float decay = expf(-tt * (lo + (float)t * ((hi - lo) / 511.0f)));
#pragma unroll
    for (int q = 0; q < 2; ++q) {
        const int n = q * 512 + t; float a = 0.f;
        for (int k = 0; k < 64; ++k) a += h2[k] * p.hy_w3[(size_t)(l * 64 + k) * 1024 + n];
        F[((size_t)q * L + pos) * 512 + t] = a * decay;
    }
    __syncthreads();
}
DEVI void ph_prep(const Params& p, char* lds) {
    float* sm = (float*)lds;
    constexpr int I_WIN = 2 * 32 * 112, I_WOUT = 2 * 32 * 32, I_MOD = 2 * 16 * 12, I_FILT = 2 * 1280, I_ROPE = 64;
    constexpr int NITEMS = I_MOD + I_WIN + I_WOUT + I_FILT + I_ROPE;
    for (int it = blockIdx.x; it < NITEMS; it += gridDim.x) {
        int r = it;
        if (r < I_MOD) { mods_item(p, r, sm); continue; } r -= I_MOD;
        if (r < I_WIN) { const int l = r / (32 * 112); transpose_item(p.w_in + (size_t)l * D * IN_W, IN_W, (bf16_t*)(p.ws + WS_WINT) + (size_t)l * IN_W * D, r % (32 * 112), sm); continue; } r -= I_WIN;
        if (r < I_WOUT) { const int l = r / (32 * 32); transpose_item(p.w_out + (size_t)l * D * D, D, (bf16_t*)(p.ws + WS_WOUTT) + (size_t)l * D * D, r % (32 * 32), sm); continue; } r -= I_WOUT;
        if (r < I_FILT) { filter_item(p, r, sm); continue; } r -= I_FILT;
        {
            const int e = r * 512 + threadIdx.x, tpos = e >> 5, axis = (e >> 4) & 1, f = e & 15;
            const float inv = powf(10000.0f, -(float)f / 16.0f), pv = (float)(axis == 0 ? (tpos >> 6) : (tpos & 63)), ang = pv * inv;
            float* RC = (float*)(p.ws + WS_ROPE);
            RC[e] = cosf(ang); RC[1024 * 32 + e] = sinf(ang);
        }
    }
}

DEVI void ph_norm(const Params& p, int l) {
    const int wid = threadIdx.x >> 6, lane = threadIdx.x & 63, gw = blockIdx.x * (NT / 64) + wid, NGW = gridDim.x * (NT / 64);
    const float* X = p.out;
    const float* MOD = (const float*)(p.ws + WS_MOD);
    bf16_t* H = (bf16_t*)(p.ws + WS_H);
    for (int row = gw; row < MT; row += NGW) {
        const float* xr = (l == 0) ? (row < MC ? p.x_prompt + (size_t)row * D : p.x_sample + (size_t)(row - MC) * D) : X + (size_t)row * D;
        const float* md = MOD + (size_t)(l * 3 + cond_of_row(row)) * 6144;
        f32x4 v[8]; float ss = 0.f;
#pragma unroll
        for (int j = 0; j < 8; ++j) { v[j] = *(const f32x4*)(xr + j * 256 + lane * 4); ss += v[j][0] * v[j][0] + v[j][1] * v[j][1] + v[j][2] * v[j][2] + v[j][3] * v[j][3]; }
        const float rs = rsqrtf(wave_sum(ss) * (1.0f / D) + 1e-6f);
#pragma unroll
        for (int j = 0; j < 8; ++j) {
            const int c0 = j * 256 + lane * 4;
            const f32x4 g = *(const f32x4*)(p.norm_g + l * D + c0), sh = *(const f32x4*)(md + c0), scl = *(const f32x4*)(md + 2048 + c0);
            bf16_t o[4];
#pragma unroll
            for (int e = 0; e < 4; ++e) o[e] = f2bf(v[j][e] * rs * g[e] * (1.0f + scl[e]) + sh[e]);
            *(uint2*)(H + (size_t)row * D + c0) = make_uint2((unsigned)o[0] | ((unsigned)o[1] << 16), (unsigned)o[2] | ((unsigned)o[3] << 16));
        }
    }
}

#define LAS __attribute__((address_space(3)))
typedef unsigned u32x4 __attribute__((ext_vector_type(4)));
constexpr int BM = 256, BK = 64, HALF = 128, HTB = HALF * BK * 2, GEMM_LDS = 8 * HTB;
DEVI int lds_byte(int r, int c) { const int st = (r >> 4) * 2 + (c >> 5), rr = r & 15, cc = c & 31, ob = rr * 64 + cc * 2; return st * 1024 + (ob ^ (((ob >> 9) & 1) << 5)); }
DEVI void stage_rc(int b, int& R, int& C) { const int st = b / 1024, sb = b % 1024, swz = sb ^ (((sb >> 9) & 1) << 5); R = (st >> 1) * 16 + swz / 64; C = (st & 1) * 32 + (swz % 64) / 2; }
DEVI int perm32(int rho) { const int n = rho >> 4, i = rho & 15; return 8 * (i >> 2) + 4 * n + (i & 3); }
struct Unit { int pm, pn; };
struct StaticOrder {
    int nM, nN, nwg, G, c;
    DEVI void init(int M, int N, int G_, int c_) { nM = M / BM; nN = N / BM; nwg = nM * nN; G = G_; c = c_; }
    DEVI bool next(int i, Unit& u) const {
        const long L = (long)i * G + c; if (L >= nwg) return false;
        int wgid = (int)L; { const int q = nwg / 8, r = nwg % 8, xcd = wgid % 8, off = wgid / 8; wgid = (xcd < r ? xcd * (q + 1) : r * (q + 1) + (xcd - r) * q) + off; }
        const int nig = 8 * nN, gid = wgid / nig, fm = gid * 8, gsz = (nM - fm) < 8 ? (nM - fm) : 8;
        u.pm = fm + ((wgid % nig) % gsz); u.pn = (wgid % nig) / gsz; return true;
    }
};
template <class Epi>
DEVI void gemm_phase(LAS unsigned char* lds, const bf16_t* gA, const bf16_t* gBt, const int K, const StaticOrder& S, const Epi& E) {
    const int tid = threadIdx.x, wid = tid >> 6, lane = tid & 63, wr = wid >> 2, wc = wid & 3, fr = lane & 15, fq = lane >> 4;
    const int nt = K / BK;
    unsigned voffA[2], voffB[2];
#pragma unroll
    for (int i = 0; i < 2; ++i) { int R, C; stage_rc(tid * 16 + i * 8192, R, C); const int Rb = Epi::PERM ? ((R & ~31) + perm32(R & 31)) : R;
        voffA[i] = (unsigned)(R * K + C) * 2u; voffB[i] = (unsigned)(Rb * K + C) * 2u; }
    const size_t kstep = (size_t)(BK * 2), hstep = (size_t)HALF * K * 2, tstep = 2 * hstep;
    const unsigned ldsw = (unsigned)wid * 1024u;
    const int aoff = lds_byte(wr * 64 + fr, fq * 8), boff = lds_byte(wc * 32 + fr, fq * 8);
#define PG8_SA(b, h) (((b) * 2 + (h)) * HTB)
#define PG8_SB(b, h) ((4 + (b) * 2 + (h)) * HTB)
#define PG8_STAGE(bufoff, gbase, voff) do { _Pragma("unroll") for (int _i = 0; _i < 2; ++_i) \
        __builtin_amdgcn_global_load_lds((const unsigned*)((const char*)(gbase) + (voff)[_i]), (LAS unsigned*)(lds + (bufoff) + ldsw + _i * 8192), 16, 0, 0); } while (0)
#define PG8_LDA(dst, b, h) do { _Pragma("unroll") for (int m = 0; m < 4; ++m) _Pragma("unroll") for (int k = 0; k < 2; ++k) dst[m][k] = *(const LAS bf16x8*)(lds + PG8_SA(b, h) + aoff + m * 2048 + k * 1024); } while (0)
#define PG8_LDB(dst, b, h) do { _Pragma("unroll") for (int n = 0; n < 2; ++n) _Pragma("unroll") for (int k = 0; k < 2; ++k) dst[n][k] = *(const LAS bf16x8*)(lds + PG8_SB(b, h) + boff + n * 2048 + k * 1024); } while (0)
#define PG8_MMA(ai, bj, At, Bt) do { __builtin_amdgcn_s_setprio(1); _Pragma("unroll") for (int m = 0; m < 4; ++m) _Pragma("unroll") for (int n = 0; n < 2; ++n) _Pragma("unroll") for (int k = 0; k < 2; ++k) \
        acc[ai][bj][m][n] = __builtin_amdgcn_mfma_f32_16x16x32_bf16(Bt[n][k], At[m][k], acc[ai][bj][m][n], 0, 0, 0); __builtin_amdgcn_s_setprio(0); } while (0)
#define PG8_WAIT_V(n) asm volatile("s_waitcnt vmcnt(" #n ")" ::: "memory")
#define PG8_WAIT_L(n) asm volatile("s_waitcnt lgkmcnt(" #n ")" ::: "memory")
#define PG8_BAR __builtin_amdgcn_s_barrier()
#define PG8_SCHED __builtin_amdgcn_sched_barrier(0)
    Unit cur, nxt; int ui = 0;
    if (!S.next(0, cur)) return;
    f32x4 acc[2][2][4][2];
#pragma unroll
    for (int a = 0; a < 2; ++a)
#pragma unroll
        for (int b = 0; b < 2; ++b)
#pragma unroll
            for (int m = 0; m < 4; ++m)
#pragma unroll
                for (int n = 0; n < 2; ++n) acc[a][b][m][n] = (f32x4){0.f, 0.f, 0.f, 0.f};
    bf16x8 At[4][2], B0[2][2], B1[2][2];
    const char* cA = (const char*)gA + (size_t)cur.pm * tstep; const char* cB = (const char*)gBt + (size_t)cur.pn * tstep;
    PG8_STAGE(PG8_SB(0, 0), cB, voffB); PG8_STAGE(PG8_SA(0, 0), cA, voffA); PG8_STAGE(PG8_SB(0, 1), cB + hstep, voffB); PG8_STAGE(PG8_SA(0, 1), cA + hstep, voffA);
    if (wr == 1) PG8_BAR;
    PG8_WAIT_V(4); PG8_BAR;
    PG8_STAGE(PG8_SB(1, 0), cB + kstep, voffB); PG8_STAGE(PG8_SA(1, 0), cA + kstep, voffA); PG8_STAGE(PG8_SB(1, 1), cB + hstep + kstep, voffB);
    PG8_WAIT_V(6); PG8_BAR;
    for (;;) {
        const bool has_next = S.next(ui + 1, nxt);
        const char* nA = has_next ? (const char*)gA + (size_t)nxt.pm * tstep : cA; const char* nB = has_next ? (const char*)gBt + (size_t)nxt.pn * tstep : cB;
        for (int t = 0; t < nt; t += 2) {
            const bool last = (t == nt - 2);
            const char* a1 = cA + (size_t)(t + 1) * kstep;
            const char* a2 = last ? nA : cA + (size_t)(t + 2) * kstep; const char* b2 = last ? nB : cB + (size_t)(t + 2) * kstep;
            const char* a3 = a2 + kstep; const char* b3 = b2 + kstep;
            PG8_LDB(B0, 0, 0); PG8_SCHED; PG8_LDA(At, 0, 0); PG8_STAGE(PG8_SA(1, 1), a1 + hstep, voffA);
            PG8_WAIT_L(8); PG8_BAR; PG8_WAIT_L(0); PG8_MMA(0, 0, At, B0); PG8_BAR; PG8_SCHED;
            PG8_LDB(B1, 0, 1); PG8_STAGE(PG8_SB(0, 0), b2, voffB);
            PG8_BAR; PG8_WAIT_L(0); PG8_MMA(0, 1, At, B1); PG8_BAR;
            PG8_LDA(At, 0, 1); PG8_STAGE(PG8_SA(0, 0), a2, voffA);
            PG8_BAR; PG8_WAIT_L(0); PG8_MMA(1, 0, At, B0); PG8_BAR; PG8_SCHED;
            PG8_STAGE(PG8_SB(0, 1), b2 + hstep, voffB);
            PG8_WAIT_V(6); PG8_BAR; PG8_MMA(1, 1, At, B1); PG8_BAR;
            PG8_LDB(B0, 1, 0); PG8_SCHED; PG8_LDA(At, 1, 0); PG8_STAGE(PG8_SA(0, 1), a2 + hstep, voffA);
            PG8_WAIT_L(8); PG8_BAR; PG8_WAIT_L(0); PG8_MMA(0, 0, At, B0); PG8_BAR; PG8_SCHED;
            PG8_LDB(B1, 1, 1); PG8_STAGE(PG8_SB(1, 0), b3, voffB);
            PG8_BAR; PG8_WAIT_L(0); PG8_MMA(0, 1, At, B1); PG8_BAR;
            PG8_LDA(At, 1, 1); PG8_STAGE(PG8_SA(1, 0), a3, voffA);
            PG8_BAR; PG8_WAIT_L(0); PG8_MMA(1, 0, At, B0); PG8_BAR; PG8_SCHED;
            PG8_STAGE(PG8_SB(1, 1), b3 + hstep, voffB);
            PG8_WAIT_V(6); PG8_BAR; PG8_MMA(1, 1, At, B1); PG8_BAR;
        }
        E(acc, cur, wr, wc, fr, fq);
        if (!has_next) break;
#pragma unroll
        for (int a = 0; a < 2; ++a)
#pragma unroll
            for (int b = 0; b < 2; ++b)
#pragma unroll
                for (int m = 0; m < 4; ++m)
#pragma unroll
                    for (int n = 0; n < 2; ++n) acc[a][b][m][n] = (f32x4){0.f, 0.f, 0.f, 0.f};
        cur = nxt; cA = nA; cB = nB; ++ui;
    }
    PG8_WAIT_V(0);
    if (wr == 0) PG8_BAR;
    PG8_BAR;
#undef PG8_SA
#undef PG8_SB
#undef PG8_STAGE
#undef PG8_LDA
#undef PG8_LDB
#undef PG8_MMA
}
DEVI unsigned pk2bf(float lo, float hi) { return (unsigned)f2bf(lo) | ((unsigned)f2bf(hi) << 16); }

struct EpiIn {
    static constexpr bool PERM = true;
    bf16_t* P; float* out; int l;
    DEVI void operator()(const f32x4 (&acc)[2][2][4][2], const Unit& u, int wr, int wc, int fr, int fq) const {
        const int row0 = u.pm * BM + wr * 64 + fr, col0 = u.pn * BM + wc * 32 + 8 * fq;
        const bool cache = (row0 < MC) && (col0 >= CK) && (col0 < CAG);
#pragma unroll
        for (int ai = 0; ai < 2; ++ai)
#pragma unroll
            for (int m = 0; m < 4; ++m) {
                const int row = row0 + ai * HALF + m * 16;
                bf16_t* rowp = P + (size_t)row * IN_W + col0;
#pragma unroll
                for (int bj = 0; bj < 2; ++bj) {
                    const f32x4 v0 = acc[ai][bj][m][0], v1 = acc[ai][bj][m][1];
                    u32x4 w; w.x = pk2bf(v0[0], v0[1]); w.y = pk2bf(v0[2], v0[3]); w.z = pk2bf(v1[0], v1[1]); w.w = pk2bf(v1[2], v1[3]);
                    *(u32x4*)(rowp + bj * HALF) = w;
                    if (cache) {
                        const int col = col0 + bj * HALF, which = col >= CV, cc = col - CK - which * 1024, b = row >> 8, t = row & 255;
                        float* o = out + (which ? OUT_V : OUT_K) + ((size_t)(b * 2 + l) * 256 + t) * 1024 + cc;
                        *(f32x4*)o = v0; *(f32x4*)(o + 4) = v1;
                    }
                }
            }
    }
};
struct EpiOut {
    static constexpr bool PERM = false;
    const float* xp; const float* xs; float* X; const float* MOD; int l;
    DEVI void operator()(const f32x4 (&acc)[2][2][4][2], const Unit& u, int wr, int wc, int fr, int fq) const {
        const int row0 = u.pm * BM + wr * 64 + fr, col0 = u.pn * BM + wc * 32 + 4 * fq;
        const float* gate = MOD + (size_t)(l * 3 + cond_of_row(u.pm * BM)) * 6144 + 4096 + col0;
#pragma unroll
        for (int bj = 0; bj < 2; ++bj)
#pragma unroll
            for (int n = 0; n < 2; ++n) {
                const f32x4 g = *(const f32x4*)(gate + bj * HALF + n * 16);
#pragma unroll
                for (int ai = 0; ai < 2; ++ai)
#pragma unroll
                    for (int m = 0; m < 4; ++m) {
                        const int row = row0 + ai * HALF + m * 16; const size_t off = (size_t)row * D + col0 + bj * HALF + n * 16;
                        const float* xin = (l == 0) ? (row < MC ? xp + off : xs + (off - (size_t)MC * D)) : X + off;
                        const f32x4 xv = *(const f32x4*)xin;
                        *(f32x4*)(X + off) = xv + g * acc[ai][bj][m][n];
                    }
            }
    }
};
DEVI void ph_gemm_in(const Params& p, int l, char* lds) {
    EpiIn e{(bf16_t*)(p.ws + WS_P), p.out, l};
    StaticOrder S; S.init(MT, IN_W, gridDim.x, blockIdx.x);
    gemm_phase((LAS unsigned char*)lds, (const bf16_t*)(p.ws + WS_H), (const bf16_t*)(p.ws + WS_WINT) + (size_t)l * IN_W * D, D, S, e);
}
DEVI void ph_gemm_out(const Params& p, int l, char* lds) {
    EpiOut e{p.x_prompt, p.x_sample, p.out, (const float*)(p.ws + WS_MOD), l};
    StaticOrder S; S.init(MT, D, gridDim.x, blockIdx.x);
    gemm_phase((LAS unsigned char*)lds, (const bf16_t*)(p.ws + WS_MIX), (const bf16_t*)(p.ws + WS_WOUTT) + (size_t)l * D * D, D, S, e);
}

DEVI void ph_rope(const Params& p) {
    bf16_t* P = (bf16_t*)(p.ws + WS_P); const float* RC = (const float*)(p.ws + WS_ROPE); const float* RS = RC + 1024 * 32;
    const int total = MS * 2048 / 2;
    for (int i = blockIdx.x * NT + threadIdx.x; i < total; i += gridDim.x * NT) {
        const int r = i / 1024, pr = i % 1024, grp = pr / 16, f = pr % 16;
        const int col = grp * 32 + f, axis = grp & 1, t = r % DSEQ;
        bf16_t* a = P + (size_t)(MC + r) * IN_W + col;
        const float av = bf2f(a[0]), bv = bf2f(a[16]), cs = RC[t * 32 + axis * 16 + f], sn = RS[t * 32 + axis * 16 + f];
        a[0] = f2bf(av * cs - bv * sn); a[16] = f2bf(bv * cs + av * sn);
    }
}

template <int NKC>
DEVI void attn_row(const Params& p, int l, int row, int h, float lam, float* qs  ) {
    const int lane = threadIdx.x & 63;
    const bf16_t* P = (const bf16_t*)(p.ws + WS_P);
    const bool smp = row >= MC;
    const int b = smp ? (row - MC) / DSEQ : row / SEQ;
    const int krow0 = smp ? MC + b * DSEQ : b * SEQ;
    { const bf16_t* q = P + (size_t)row * IN_W + CQ + h * 128; qs[lane] = bf2f(q[lane]) * 0.125f; qs[64 + lane] = bf2f(q[64 + lane]) * 0.125f; }
    __builtin_amdgcn_wave_barrier();
    float s0[NKC], s1[NKC];
#pragma unroll
    for (int j = 0; j < NKC; ++j) {
        const int key = j * 64 + lane; float a0 = 0.f, a1 = 0.f;
        if (smp && key < PAST) {
            const float* kp = p.cache_k + (((size_t)(b * 2 + l) * PAST + key) * NH + h) * 128;
#pragma unroll 4
            for (int d = 0; d < 64; ++d) { a0 += qs[d] * kp[d]; a1 += qs[64 + d] * kp[64 + d]; }
        } else {
            const bf16_t* kp = P + (size_t)(krow0 + (smp ? key - PAST : key)) * IN_W + CK + h * 128;
#pragma unroll 4
            for (int d = 0; d < 64; ++d) { a0 += qs[d] * bf2f(kp[d]); a1 += qs[64 + d] * bf2f(kp[64 + d]); }
        }
        s0[j] = a0; s1[j] = a1;
    }
    float m0 = -1e30f, m1 = -1e30f;
#pragma unroll
    for (int j = 0; j < NKC; ++j) { m0 = fmaxf(m0, s0[j]); m1 = fmaxf(m1, s1[j]); }
    m0 = wave_max(m0); m1 = wave_max(m1);
    float l0 = 0.f, l1 = 0.f;
#pragma unroll
    for (int j = 0; j < NKC; ++j) { s0[j] = expf(s0[j] - m0); s1[j] = expf(s1[j] - m1); l0 += s0[j]; l1 += s1[j]; }
    l0 = wave_sum(l0); l1 = wave_sum(l1);
    const float i0 = 1.0f / l0, i1 = lam / l1;
#pragma unroll
    for (int j = 0; j < NKC; ++j) s0[j] = s0[j] * i0 - s1[j] * i1;
    float o0 = 0.f, o1 = 0.f;
#pragma unroll
    for (int j = 0; j < NKC; ++j) {
#pragma unroll 2
        for (int src = 0; src < 64; ++src) {
            const float w = __shfl(s0[j], src); const int key = j * 64 + src;
            if (smp && key < PAST) { const float* vp = p.cache_v + (((size_t)(b * 2 + l) * PAST + key) * NH + h) * 128 + 2 * lane; o0 += w * vp[0]; o1 += w * vp[1]; }
            else { const bf16_t* vp = P + (size_t)(krow0 + (smp ? key - PAST : key)) * IN_W + CV + h * 128 + 2 * lane; o0 += w * bf2f(vp[0]); o1 += w * bf2f(vp[1]); }
        }
    }
    const float rs = rsqrtf(wave_sum(o0 * o0 + o1 * o1) * (1.0f / 128.0f) + 1e-6f) * (1.0f - lam_init_of(l));
    const float* g = p.subln_g + l * 128 + 2 * lane; const bf16_t* ag = P + (size_t)row * IN_W + CAG + h * 128 + 2 * lane;
    bf16_t* mx = (bf16_t*)(p.ws + WS_MIX) + (size_t)row * D + h * 128 + 2 * lane;
    mx[0] = f2bf(o0 * rs * g[0] * silu_f(bf2f(ag[0]))); mx[1] = f2bf(o1 * rs * g[1] * silu_f(bf2f(ag[1])));
    __builtin_amdgcn_wave_barrier();
}
DEVI void ph_attn(const Params& p, int l, char* lds) {
    const int wid = threadIdx.x >> 6, lane = threadIdx.x & 63, gw = blockIdx.x * (NT / 64) + wid, NGW = gridDim.x * (NT / 64);
    float* qs = (float*)lds + wid * 128;
    const float d1 = wave_sum(p.lam_q1[l * 64 + lane] * p.lam_k1[l * 64 + lane]), d2 = wave_sum(p.lam_q2[l * 64 + lane] * p.lam_k2[l * 64 + lane]);
    const float lam = expf(d1) - expf(d2) + lam_init_of(l);
    for (int it = gw; it < MT * NH; it += NGW) {
        const int row = (it < MS * NH) ? MC + it / NH : (it - MS * NH) / NH, h = it % NH;
        if (row >= MC) attn_row<24>(p, l, row, h, lam, qs); else attn_row<4>(p, l, row, h, lam, qs);
    }
}

DEVI void seq_of_row(int row, int& t, int& L) { if (row < MC) { t = row & 255; L = SEQ; } else { t = (row - MC) & 1023; L = DSEQ; } }

DEVI void ph_conv(const Params& p, int l) {
    const bf16_t* P = (const bf16_t*)(p.ws + WS_P);
    float* XC = (float*)(p.ws + WS_XC); float* HYV = (float*)(p.ws + WS_HYV); float* HX0C = (float*)(p.ws + WS_HX0C);
    for (int i = blockIdx.x * NT + threadIdx.x; i < MT * 512; i += gridDim.x * NT) {
        const int row = i >> 9, ch = i & 511; int t, L; seq_of_row(row, t, L);
        {
            float a = p.lru_conv_b[l * 512 + ch];
#pragma unroll
            for (int j = 0; j < 4; ++j) { const int tt = t + j - 2; if (tt >= 0 && tt < L) a += p.lru_conv_w[(l * 4 + j) * 512 + ch] * bf2f(P[(size_t)(row + j - 2) * IN_W + CLX + ch]); }
            XC[i] = a;
        }
        float u[3];
#pragma unroll
        for (int g = 0; g < 3; ++g) {
            const int c3 = g * 512 + ch; float a = p.hy_conv_b[l * 1536 + c3];
#pragma unroll
            for (int j = 0; j < 3; ++j) { const int tt = t + j - 1; if (tt >= 0 && tt < L) a += p.hy_conv_w[(l * 3 + j) * 1536 + c3] * bf2f(P[(size_t)(row + j - 1) * IN_W + CHV + c3]); }
            u[g] = a;
        }
        HYV[i] = u[1] * u[0]; HX0C[i] = u[2];
    }
}
DEVI void ph_lru_gate(const Params& p, int l) {
    const float* XC = (const float*)(p.ws + WS_XC);
    float* AF = (float*)(p.ws + WS_AF); float* BF = (float*)(p.ws + WS_BF); float* AB = (float*)(p.ws + WS_AB); float* BB = (float*)(p.ws + WS_BB);
    for (int i = blockIdx.x * NT + threadIdx.x; i < MT * 512; i += gridDim.x * NT) {
        const int row = i >> 9, ch = i & 511, n = ch >> 6, d = ch & 63;
        const float* xr = XC + (size_t)row * 512 + n * 64; const float xc = xr[d];
#pragma unroll
        for (int dir = 0; dir < 2; ++dir) {
            const float* wa = p.lru_wa + ((size_t)((l * 2 + dir) * 8 + n) * 64) * 64 + d; const float* wi = p.lru_wi + ((size_t)((l * 2 + dir) * 8 + n) * 64) * 64 + d;
            float ra = p.lru_ba[(l * 2 + dir) * 512 + ch], ia = p.lru_bi[(l * 2 + dir) * 512 + ch];
            for (int c = 0; c < 64; ++c) { const float x = xr[c]; ra += x * wa[c * 64]; ia += x * wi[c * 64]; }
            const float r = sigmoid_f(ra), ig = sigmoid_f(ia);
            const float lam = p.lru_lam[(l * 2 + dir) * 512 + ch];
            const float sp = log1pf(expf(-lam));
            const float log_a = -8.0f * r * sp, a = expf(log_a), bb = sqrtf(-expm1f(2.0f * log_a)) * (ig * xc);
            if (dir == 0) { AF[i] = a; BF[i] = bb; } else { AB[i] = a; BB[i] = bb; }
        }
    }
}
DEVI void ph_lru_scan(const Params& p, int l, int dir) {
    const float* Aa = (const float*)(p.ws + (dir ? WS_AB : WS_AF)); const float* Ba = (const float*)(p.ws + (dir ? WS_BB : WS_BF));
    float* HS = (float*)(p.ws + WS_HS); const bf16_t* P = (const bf16_t*)(p.ws + WS_P); bf16_t* MIX = (bf16_t*)(p.ws + WS_MIX);
    for (int i = blockIdx.x * NT + threadIdx.x; i < 34 * 512; i += gridDim.x * NT) {
        const int sq = i >> 9, ch = i & 511; const bool smp = sq < 2; const int b = smp ? sq : sq - 2;
        const int L = smp ? DSEQ : SEQ, row0 = smp ? MC + b * DSEQ : b * SEQ;
        float h = smp ? p.state_lru[((b * 2 + l) * 2 + dir) * 512 + ch] : 0.f;
        for (int s = 0; s < L; ++s) {
            const int t = dir ? L - 1 - s : s; const size_t idx = (size_t)(row0 + t) * 512 + ch;
            h = Aa[idx] * h + Ba[idx];
            if (dir == 0) HS[idx] = h;
            else MIX[(size_t)(row0 + t) * D + 1024 + ch] = f2bf((HS[idx] + h) * silu_f(bf2f(P[(size_t)(row0 + t) * IN_W + CLG + ch])));
        }
        if (!smp) p.out[OUT_ST + ((size_t)(b * 2 + l) * 2 + dir) * 512 + ch] = h;
    }
}
DEVI void ph_hy_long(const Params& p, int l) {
    const float* HYV = (const float*)(p.ws + WS_HYV); const float* HX0C = (const float*)(p.ws + WS_HX0C);
    const bf16_t* P = (const bf16_t*)(p.ws + WS_P); bf16_t* MIX = (bf16_t*)(p.ws + WS_MIX);
    const float* FL = (const float*)(p.ws + WS_FILT) + (size_t)l * FILT_PER_LAYER;
    for (int i = blockIdx.x * NT + threadIdx.x; i < MT * 512; i += gridDim.x * NT) {
        const int ii = (i < MS * 512) ? i + MC * 512 : i - MS * 512;
        const int row = ii >> 9, ch = ii & 511; int t, L; seq_of_row(row, t, L);
        const float* ff = FL + (L == DSEQ ? (size_t)2 * 256 * 512 : 0); const float* fb = ff + (size_t)L * 512;
        const float* v0 = HYV + (size_t)(row - t) * 512 + ch;
        float y = p.hy_d[l * 512 + ch] * v0[(size_t)t * 512];
        for (int s = 0; s <= t; ++s) y += ff[(size_t)(t - s) * 512 + ch] * v0[(size_t)s * 512];
        for (int s = t + 1; s < L; ++s) y += fb[(size_t)(s - t) * 512 + ch] * v0[(size_t)s * 512];
        MIX[(size_t)row * D + 1536 + ch] = f2bf(HX0C[ii] * y * silu_f(bf2f(P[(size_t)row * IN_W + CHG + ch])));
    }
}
DEVI void ph_final(const Params& p) {
    const int wid = threadIdx.x >> 6, lane = threadIdx.x & 63, gw = blockIdx.x * (NT / 64) + wid, NGW = gridDim.x * (NT / 64);
    for (int row = gw; row < MT; row += NGW) {
        float* xr = p.out + (size_t)row * D;
        f32x4 v[8]; float ss = 0.f;
#pragma unroll
        for (int j = 0; j < 8; ++j) { v[j] = *(const f32x4*)(xr + j * 256 + lane * 4); ss += v[j][0] * v[j][0] + v[j][1] * v[j][1] + v[j][2] * v[j][2] + v[j][3] * v[j][3]; }
        const float rs = rsqrtf(wave_sum(ss) * (1.0f / D) + 1e-6f);
#pragma unroll
        for (int j = 0; j < 8; ++j) { const f32x4 g = *(const f32x4*)(p.final_g + j * 256 + lane * 4); *(f32x4*)(xr + j * 256 + lane * 4) = v[j] * rs * g; }
    }
}

enum { PH_PREP = 0, PH_NORM, PH_GEMM_IN, PH_ROPE, PH_MIX_A, PH_LRU_GATE, PH_LRU_SF, PH_LRU_SB, PH_HY_LONG, PH_GEMM_OUT, PH_FINAL };

template <int ph> __global__ void __launch_bounds__(NT, 2) k_phase(Params p, int l) {
    extern __shared__ __attribute__((aligned(16))) char lds[];
    switch (ph) {
        case PH_PREP: ph_prep(p, lds); break;
        case PH_NORM: ph_norm(p, l); break;
        case PH_GEMM_IN: ph_gemm_in(p, l, lds); break;
        case PH_ROPE: ph_rope(p); break;
        case PH_MIX_A: ph_conv(p, l); ph_attn(p, l, lds); break;
        case PH_LRU_GATE: ph_lru_gate(p, l); break;
        case PH_LRU_SF: ph_lru_scan(p, l, 0); break;
        case PH_LRU_SB: ph_lru_scan(p, l, 1); break;
        case PH_HY_LONG: ph_hy_long(p, l); break;
        case PH_GEMM_OUT: ph_gemm_out(p, l, lds); break;
        case PH_FINAL: ph_final(p); break;
    }
}

extern "C" void kernel_launch(void* const* d_in, const int* in_sizes, int n_in, void* d_out, int out_size, void* d_ws, size_t ws_size, hipStream_t stream) {
    static int ok = 0;
    if (ok == 0) {
        if (n_in != 33 || ws_size < WS_END) { fprintf(stderr, "kernel_launch: n_in %d ws %zu need %zu\n", n_in, ws_size, (size_t)WS_END); ok = -1; return; }
        if (hipFuncSetAttribute((const void*)k_phase<PH_GEMM_IN>, hipFuncAttributeMaxDynamicSharedMemorySize, GEMM_LDS) != hipSuccess || hipFuncSetAttribute((const void*)k_phase<PH_GEMM_OUT>, hipFuncAttributeMaxDynamicSharedMemorySize, GEMM_LDS) != hipSuccess) { fprintf(stderr, "hipFuncSetAttribute failed\n"); ok = -1; return; }
        ok = 1;
    }
    if (ok < 0) return;
    Params p{};
    const float** pp = (const float**)&p;
    for (int i = 0; i < 33; ++i) pp[i] = (const float*)d_in[i];
    p.out = (float*)d_out; p.ws = (unsigned char*)d_ws;
    (void)hipMemsetAsync((char*)d_ws + WS_CTL, 0, 65536 + MOD_BYTES, stream);
    const int G = 256;
#define LAUNCH(ph, l) hipLaunchKernelGGL(k_phase<ph>, dim3(G), dim3(NT), ((ph) == PH_GEMM_IN || (ph) == PH_GEMM_OUT) ? GEMM_LDS : 32768, stream, p, (int)(l))
    LAUNCH(PH_PREP, 0);
    for (int l = 0; l < DEPTH; ++l) {
        LAUNCH(PH_NORM, l); LAUNCH(PH_GEMM_IN, l); LAUNCH(PH_ROPE, l); LAUNCH(PH_MIX_A, l); LAUNCH(PH_LRU_GATE, l);
        LAUNCH(PH_LRU_SF, l); LAUNCH(PH_LRU_SB, l); LAUNCH(PH_HY_LONG, l); LAUNCH(PH_GEMM_OUT, l);
    }
    LAUNCH(PH_FINAL, 0);
}
```

```cpp
#include <hip/hip_runtime.h>
#include <hip/hip_cooperative_groups.h>
#include <cstdint>
#include <cstdio>
#include <type_traits>

#define DEVI __device__ __forceinline__
typedef unsigned short bf16_t;
using bf16x8 = __attribute__((ext_vector_type(8))) short;
using f32x4 = __attribute__((ext_vector_type(4))) float;

constexpr int D = 2048, NB = 32, SEQ = 256, DEPTH = 2, DB = 2, DSEQ = 1024, PAST = 512;
constexpr int NH = 8, IN_W = 7168;
constexpr int MC = NB * SEQ, MS = DB * DSEQ, MT = MC + MS;
constexpr int CQ = 0, CK = 1024, CV = 2048, CAG = 3072, CLX = 4096, CLG = 4608, CHV = 5120, CHX1 = 5632, CHX0 = 6144, CHG = 6656;
constexpr int NT = 512;

constexpr size_t OUT_YP = 0, OUT_YS = (size_t)MC * D, OUT_K = (size_t)MT * D, OUT_V = OUT_K + (size_t)NB * DEPTH * SEQ * 1024,
                 OUT_ST = OUT_V + (size_t)NB * DEPTH * SEQ * 1024;

constexpr size_t WS_CTL = 0;
constexpr size_t WS_MOD = 65536;
constexpr size_t MOD_BYTES = (size_t)2 * 3 * 6144 * 4;
constexpr size_t WS_ROPE = WS_MOD + MOD_BYTES;
constexpr size_t WS_FILT = WS_ROPE + 2 * 1024 * 32 * 4;
constexpr size_t FILT_PER_LAYER = (size_t)2 * 256 * 512 + (size_t)2 * 1024 * 512;
constexpr size_t WS_CKB = WS_FILT + 2 * FILT_PER_LAYER * 4;
constexpr size_t CACHE_ELEMS = (size_t)DB * DEPTH * PAST * 1024;
constexpr size_t WS_CVB = WS_CKB + CACHE_ELEMS * 2;
constexpr size_t WS_WGB = WS_CVB + CACHE_ELEMS * 2;
constexpr size_t WS_WINT = WS_WGB + (size_t)2 * 8 * 2 * 2 * 64 * 64 * 2;
constexpr size_t WS_WOUTT = WS_WINT + (size_t)2 * IN_W * D * 2;
constexpr size_t WS_H = WS_WOUTT + (size_t)2 * D * D * 2;
constexpr size_t WS_P = WS_H + (size_t)MT * D * 2;
constexpr size_t WS_MIX = WS_P + (size_t)MT * IN_W * 2;
constexpr size_t SCR1 = (size_t)MT * 512 * 4;
constexpr size_t WS_HS = WS_MIX + (size_t)MT * D * 2;
constexpr size_t WS_SA = WS_HS + SCR1, WS_SB = WS_SA + SCR1;
constexpr size_t WS_GS = WS_SB + SCR1;
constexpr size_t GS_L256 = (size_t)512 * 512, GS_PER_LAYER = GS_L256 + (size_t)512 * 2048;
constexpr size_t WS_PH = WS_GS + 2 * GS_PER_LAYER * 2;
constexpr size_t WS_END = WS_PH + (size_t)MT * 2048 * 2;

struct Params {
    const float *x_prompt, *x_sample, *cache_k, *cache_v, *state_lru, *c, *c_ctx, *norm_g, *w_ada, *b_ada, *w_in, *w_out,
        *lam_q1, *lam_k1, *lam_q2, *lam_k2, *subln_g, *lru_conv_w, *lru_conv_b, *lru_wa, *lru_ba, *lru_wi, *lru_bi, *lru_lam,
        *hy_conv_w, *hy_conv_b, *hy_w1, *hy_b1, *hy_w2, *hy_b2, *hy_w3, *hy_d, *final_g;
    float* out; unsigned char* ws;
};

#define LAS __attribute__((address_space(3)))
constexpr int LDS_QSLOT = 131072, LDS_WTAB = LDS_QSLOT + 64, LDS_TOTAL = LDS_QSLOT + 64 + 256;
DEVI char* dyn_lds() { extern __shared__ __attribute__((aligned(16))) char lds_dyn_[]; return lds_dyn_; }
DEVI int opaque_tid() {
    const unsigned hw = (unsigned)__builtin_amdgcn_s_getreg((5 << 11) | 4) & 63u;
    int wv = ((volatile LAS int*)(dyn_lds() + LDS_WTAB))[hw];
    wv = __builtin_amdgcn_readfirstlane(wv);
    int lane; asm volatile("v_mbcnt_lo_u32_b32 %0, -1, 0\n\tv_mbcnt_hi_u32_b32 %0, -1, %0" : "=v"(lane));
    return wv * 64 + lane;
}
#define TIDX opaque_tid()
typedef const __attribute__((address_space(4))) Params* KP;
DEVI KP kparams() { KP k = (KP)__builtin_amdgcn_kernarg_segment_ptr(); asm volatile("" : "+s"(k)); return k; }
#if defined(__HIP_DEVICE_COMPILE__)
#define KPARAMS(name) const Params name = *kparams()
#else
#define KPARAMS(name) const Params name{}
#endif
DEVI bf16_t f2bf(float f) { unsigned u = __float_as_uint(f); u += 0x7fffu + ((u >> 16) & 1u); return (bf16_t)(u >> 16); }
typedef unsigned u32x4 __attribute__((ext_vector_type(4)));
typedef __bf16 bf16x2_t __attribute__((ext_vector_type(2)));
typedef float f32x2_t __attribute__((ext_vector_type(2)));
DEVI unsigned pk2bf(float lo, float hi) { const f32x2_t v = {lo, hi}; return __builtin_bit_cast(unsigned, __builtin_convertvector(v, bf16x2_t)); }
DEVI float bf2f(bf16_t h) { return __uint_as_float(((unsigned)h) << 16); }
DEVI float silu_f(float x) { return x / (1.f + expf(-x)); }
DEVI float sigmoid_f(float x) { return 1.f / (1.f + expf(-x)); }
DEVI float lru_fsig(float x) { return __builtin_amdgcn_rcpf(1.0f + __builtin_amdgcn_exp2f(-1.4426950408889634f * x)); }
template <int K> DEVI float swz_xor(float v) { return __int_as_float(__builtin_amdgcn_ds_swizzle(__float_as_int(v), 0x1f | (K << 10))); }
DEVI float half_sum(float v) { v += swz_xor<1>(v); v += swz_xor<2>(v); v += swz_xor<4>(v); v += swz_xor<8>(v); v += swz_xor<16>(v); return v; }
DEVI float wave_sum(float v) { v = half_sum(v); auto rr = __builtin_amdgcn_permlane32_swap(__float_as_uint(v), __float_as_uint(v), false, false); return __uint_as_float(rr[0]) + __uint_as_float(rr[1]); }
DEVI int cond_of_row(int row) { return row < MC ? 0 : 1 + (row - MC) / DSEQ; }
DEVI float lam_init_of(int l) { return l == 0 ? 0.2f : (0.8f - 0.6f * 0.74081822068171786607f); }

struct TrItem { const float* W; bf16_t* WT; int N, k0, n0; };
DEVI TrItem tr_decode(const Params& p, int r) {
    TrItem it;
    if (r < 3584) { const int l = r / 1792, q = r % 1792; it.W = p.w_in + (size_t)l * D * IN_W; it.WT = (bf16_t*)(p.ws + WS_WINT) + (size_t)l * IN_W * D; it.N = IN_W; it.k0 = (q / 56) * 64; it.n0 = (q % 56) * 128; }
    else { const int r2 = r - 3584, l = r2 / 512, q = r2 % 512; it.W = p.w_out + (size_t)l * D * D; it.WT = (bf16_t*)(p.ws + WS_WOUTT) + (size_t)l * D * D; it.N = D; it.k0 = (q / 16) * 64; it.n0 = (q % 16) * 128; }
    return it;
}
DEVI void tr_load(const TrItem& it, int t, f32x4 (&r)[4]) {
#pragma unroll
    for (int i = 0; i < 4; ++i) { const int idx = i * 512 + t, row = idx >> 5, c4 = idx & 31; r[i] = *(const f32x4*)(it.W + (size_t)(it.k0 + row) * it.N + it.n0 + c4 * 4); }
}
DEVI void tr_store(const TrItem& it, int t, const f32x4 (&r)[4], float* tile  ) {
#pragma unroll
    for (int i = 0; i < 4; ++i) { const int idx = i * 512 + t, row = idx >> 5, c4 = idx & 31;
#pragma unroll
        for (int e = 0; e < 4; ++e) tile[row * 129 + c4 * 4 + e] = r[i][e]; }
    __syncthreads();
#pragma unroll
    for (int j = 0; j < 2; ++j) { const int o = j * 512 + t, kg = o & 7, n = o >> 3; float v[8];
#pragma unroll
        for (int e = 0; e < 8; ++e) v[e] = tile[(kg * 8 + e) * 129 + n];
        u32x4 w; w.x = pk2bf(v[0], v[1]); w.y = pk2bf(v[2], v[3]); w.z = pk2bf(v[4], v[5]); w.w = pk2bf(v[6], v[7]);
        *(u32x4*)(it.WT + (size_t)(it.n0 + n) * D + it.k0 + kg * 8) = w; }
    __syncthreads();
}
DEVI void mods_item(const Params& p, int item, float* sc  ) {
    const int l = item / 96, kc = (item / 3) % 32, nb = item % 3, t = TIDX;
    float* MOD = (float*)(p.ws + WS_MOD);
    if (t < 192) { const int j = t >> 6, kk = t & 63, k = kc * 64 + kk; const float cv = (j == 0) ? p.c_ctx[k] : p.c[(j - 1) * D + k]; sc[j * 64 + kk] = silu_f(cv); }
    __syncthreads();
    const int n = nb * 2048 + t * 4; f32x4 a0 = {0.f, 0.f, 0.f, 0.f}, a1 = a0, a2 = a0;
    const float* w = p.w_ada + ((size_t)l * D + kc * 64) * 6144 + n;
#pragma unroll 16
    for (int kk = 0; kk < 64; ++kk) { const f32x4 wv = *(const f32x4*)(w + (size_t)kk * 6144); a0 += sc[kk] * wv; a1 += sc[64 + kk] * wv; a2 += sc[128 + kk] * wv; }
    if (kc == 0) { const f32x4 bv = *(const f32x4*)(p.b_ada + l * 6144 + n); a0 += bv; a1 += bv; a2 += bv; }
#pragma unroll
    for (int e = 0; e < 4; ++e) { atomicAdd(&MOD[(l * 3 + 0) * 6144 + n + e], a0[e]); atomicAdd(&MOD[(l * 3 + 1) * 6144 + n + e], a1[e]); atomicAdd(&MOD[(l * 3 + 2) * 6144 + n + e], a2[e]); }
    __syncthreads();
}
DEVI void filter_item(const Params& p, int item, float* sm  ) {
    const int l = item / 80, r = item % 80, Lsel = r >= 16, pos0 = (Lsel ? r - 16 : r) * 16, L = Lsel ? 1024 : 256, t = TIDX;
    float* z = sm; float* h1 = sm + 16 * 36; float* h2 = h1 + 16 * 64;
    {
        const int pp = t >> 5, q = t & 31;
        const int pos = pos0 + pp; const float tt = (float)pos / (float)(L - 1);
        const int i = q & 15; const float band = 1e-4f + (float)i * ((15.0f - 1e-4f) / 15.0f); const float ang = (6.283185307179586f / (float)L) * (float)pos * band;
        z[pp * 36 + 1 + q] = (q < 16) ? cosf(ang) : sinf(ang);
        if (q == 0) z[pp * 36] = tt;
    }
    __syncthreads();
#pragma unroll
    for (int e = 0; e < 2; ++e) { const int idx = e * 512 + t, pp = idx >> 6, j = idx & 63; float a = p.hy_b1[l * 64 + j]; float w[33];
        _Pragma("unroll") for (int i = 0; i < 33; ++i) w[i] = p.hy_w1[(l * 33 + i) * 64 + j];
        _Pragma("unroll") for (int i = 0; i < 33; ++i) a += z[pp * 36 + i] * w[i]; h1[pp * 64 + j] = sinf(a); }
    __syncthreads();
#pragma unroll
    for (int e = 0; e < 2; ++e) { const int idx = e * 512 + t, pp = idx >> 6, j = idx & 63; float a = p.hy_b2[l * 64 + j];
        _Pragma("unroll 1") for (int i0 = 0; i0 < 64; i0 += 32) { float w[32];
            _Pragma("unroll") for (int i = 0; i < 32; ++i) w[i] = p.hy_w2[(l * 64 + i0 + i) * 64 + j];
            _Pragma("unroll") for (int i = 0; i < 32; ++i) a += h1[pp * 64 + i0 + i] * w[i]; }
        h2[pp * 64 + j] = sinf(a); }
    __syncthreads();
    float* F = (float*)(p.ws + WS_FILT) + (size_t)l * FILT_PER_LAYER + (Lsel ? (size_t)2 * 256 * 512 : 0);
    const float lo = 3.0701134573253945f, hi = 15.350567286626973f, delta = lo + (float)t * ((hi - lo) / 511.0f);
#pragma unroll
    for (int q = 0; q < 2; ++q) {
        const int n = q * 512 + t; float a[16];
#pragma unroll
        for (int pp = 0; pp < 16; ++pp) a[pp] = 0.f;
#pragma unroll 1
        for (int k0 = 0; k0 < 64; k0 += 16) { float w[16];
#pragma unroll
            for (int k = 0; k < 16; ++k) w[k] = p.hy_w3[(size_t)(l * 64 + k0 + k) * 1024 + n];
#pragma unroll
            for (int k = 0; k < 16; ++k)
#pragma unroll
                for (int pp = 0; pp < 16; ++pp) a[pp] += h2[pp * 64 + k0 + k] * w[k]; }
        float* dst = F + ((size_t)q * 512 + t) * L + pos0;
#pragma unroll
        for (int g = 0; g < 4; ++g) { f32x4 o;
#pragma unroll
            for (int e = 0; e < 4; ++e) { const int pp = g * 4 + e; o[e] = a[pp] * expf(-((float)(pos0 + pp) / (float)(L - 1)) * delta); }
            *(f32x4*)(dst + g * 4) = o; }
    }
    __syncthreads();
}
DEVI void gs_item(const Params& p, int it) {
    const int t = TIDX;
    {
        const int l = it >> 7, Lsel = (it >> 6) & 1, c8 = (it & 63) * 8, L = Lsel ? 1024 : 256;
        const float* F0 = (const float*)(p.ws + WS_FILT) + (size_t)l * FILT_PER_LAYER + (Lsel ? (size_t)2 * 256 * 512 : 0);
        bf16_t* G0 = (bf16_t*)(p.ws + WS_GS) + (size_t)l * GS_PER_LAYER + (Lsel ? GS_L256 : 0);
        const int nchunk = 8 * 2 * L / 8;
        for (int cidx = t; cidx < nchunk; cidx += NT) {
            const int c = cidx / (2 * L / 8), i0 = (cidx % (2 * L / 8)) * 8, ch = c8 + c;
            const float* Ff = F0 + (size_t)ch * L; const float* Fb = Ff + (size_t)512 * L; const float dsk = p.hy_d[l * 512 + ch];
            float v[8];
#pragma unroll
            for (int e = 0; e < 8; ++e) { const int d = L - 1 - (i0 + e); float g = 0.f;
                if (d > 0 && d < L) g = Ff[d]; else if (d < 0 && -d < L) g = Fb[-d]; else if (d == 0) g = Ff[0] + dsk;
                v[e] = g; }
            u32x4 w; w.x = pk2bf(v[0], v[1]); w.y = pk2bf(v[2], v[3]); w.z = pk2bf(v[4], v[5]); w.w = pk2bf(v[6], v[7]);
            *(u32x4*)(G0 + (size_t)ch * 2 * L + i0) = w;
        }
    }
}
DEVI void small_item(const Params& p, int kind, int r, int t) {
    if (kind == 0) {
        const int e = r * 512 + t, c = e & 63, d = (e >> 6) & 63, gate = (e >> 12) & 1, dir = (e >> 13) & 1, n = (e >> 14) & 7, l = e >> 17;
        const float* src = gate ? p.lru_wi : p.lru_wa;
        ((bf16_t*)(p.ws + WS_WGB))[e] = f2bf(src[((size_t)((l * 2 + dir) * 8 + n) * 64 + c) * 64 + d]);
    } else if (kind == 1) {
        const size_t e = ((size_t)r * 512 + t) * 8; const bool isv = e >= CACHE_ELEMS; const size_t o = isv ? e - CACHE_ELEMS : e;
        const float* src = (isv ? p.cache_v : p.cache_k) + o; const f32x4 x0 = *(const f32x4*)src, x1 = *(const f32x4*)(src + 4);
        u32x4 w; w.x = pk2bf(x0[0], x0[1]); w.y = pk2bf(x0[2], x0[3]); w.z = pk2bf(x1[0], x1[1]); w.w = pk2bf(x1[2], x1[3]);
        *(u32x4*)((bf16_t*)(p.ws + (isv ? WS_CVB : WS_CKB)) + o) = w;
    } else {
        const int e = r * 512 + t, tpos = e >> 5, axis = (e >> 4) & 1, f = e & 15;
        const float inv = powf(10000.0f, -(float)f / 16.0f), pv = (float)(axis == 0 ? (tpos >> 6) : (tpos & 63)), ang = pv * inv;
        float* RC = (float*)(p.ws + WS_ROPE);
        RC[e] = cosf(ang); RC[1024 * 32 + e] = sinf(ang);
    }
}
constexpr int I_MOD = 192, I_FILT = 2 * 80, I_ROPE = 64, I_CACHE = (int)(2 * CACHE_ELEMS / (512 * 8)), I_WG = 2 * 8 * 2 * 2 * 64 * 64 / 512, I_TR0 = 1792, I_TR = 3584 + 1024, I_GS = 256;
DEVI void ph_prep(const Params& p, char* lds) {
    float* sm = (float*)lds;
    const int t = TIDX;
    for (int it = blockIdx.x; it < 96 + 80 + I_ROPE; it += gridDim.x) {
        int r = it;
        if (r < 96) { mods_item(p, r, sm); continue; } r -= 96;
        if (r < 80) { filter_item(p, r, sm); continue; } r -= 80;
        small_item(p, 2, r, t);
    }
    __syncthreads();
    {
        int it = blockIdx.x; f32x4 cur[4], nxt[4]; TrItem ci, ni;
        if (it < I_TR0) { ci = tr_decode(p, it); tr_load(ci, t, cur); }
        while (it < I_TR0) {
            const int itn = it + gridDim.x; const bool more = itn < I_TR0;
            if (more) { ni = tr_decode(p, itn); tr_load(ni, t, nxt); }
            tr_store(ci, t, cur, sm);
            if (more) { ci = ni;
#pragma unroll
                for (int i = 0; i < 4; ++i) cur[i] = nxt[i]; }
            it = itn;
        }
    }
}
DEVI void tr_batch(const Params& p, int first, int count, int t, float* sm) {
    f32x4 cur[4], nxt[4]; TrItem ci = tr_decode(p, first), ni = ci;
    tr_load(ci, t, cur);
#pragma unroll 1
    for (int k = 0; k < count; ++k) {
        const bool more = k + 1 < count;
        if (more) { ni = tr_decode(p, first + k + 1); tr_load(ni, t, nxt); }
        tr_store(ci, t, cur, sm);
        if (more) { ci = ni;
#pragma unroll
            for (int i = 0; i < 4; ++i) cur[i] = nxt[i]; }
    }
}
DEVI void ph_filler(const Params& p, char* lds, int stage) {
    float* sm = (float*)lds;
    const int t = TIDX;
    const int NF = 96 + 80 + 128 + 128 + I_CACHE / 8 + I_WG / 8 + 128 + 448 + 128;
    unsigned* qctr = (unsigned*)(p.ws + WS_CTL) + 2048 + 64 * stage;
    volatile int* slot = (volatile int*)(lds + LDS_QSLOT);
    for (;;) {
        __syncthreads();
        if (t == 0) *slot = (int)__hip_atomic_fetch_add(qctr, 1u, __ATOMIC_RELAXED, __HIP_MEMORY_SCOPE_AGENT);
        __syncthreads();
        int r = __builtin_amdgcn_readfirstlane(*slot);
        if (r >= NF) break;
        if (stage == 0) {
            if (r < 96) { mods_item(p, 96 + r, sm); continue; } r -= 96;
            if (r < 80) { filter_item(p, 80 + r, sm); continue; } r -= 80;
            if (r < 128) { gs_item(p, r); continue; } r -= 128;
            if (r < 128) { tr_batch(p, 3584 + 4 * r, 4, t, sm); continue; } r -= 128;
            if (r < I_CACHE / 8) { for (int k = 0; k < 8; ++k) small_item(p, 1, r * 8 + k, t); continue; } r -= I_CACHE / 8;
            if (r < I_WG / 8) { for (int k = 0; k < 8; ++k) small_item(p, 0, r * 8 + k, t); continue; } r -= I_WG / 8;
            if (r < 128) { gs_item(p, 128 + r); continue; } r -= 128;
            if (r < 448) { tr_batch(p, 1792 + 4 * r, 4, t, sm); continue; } r -= 448;
            tr_batch(p, 3584 + 512 + 4 * r, 4, t, sm);
        }
    }
}

DEVI void ph_norm(const Params& p, int l) {
    const int wid = TIDX >> 6, lane = TIDX & 63, gw = blockIdx.x * (NT / 64) + wid, NGW = gridDim.x * (NT / 64);
    const float* X = p.out;
    const float* MOD = (const float*)(p.ws + WS_MOD);
    bf16_t* H = (bf16_t*)(p.ws + WS_H);
    for (int row = gw; row < MT; row += NGW) {
        const float* xr = (l == 0) ? (row < MC ? p.x_prompt + (size_t)row * D : p.x_sample + (size_t)(row - MC) * D) : X + (size_t)row * D;
        const float* md = MOD + (size_t)(l * 3 + cond_of_row(row)) * 6144;
        f32x4 v[8]; float ss = 0.f;
#pragma unroll
        for (int j = 0; j < 8; ++j) { v[j] = *(const f32x4*)(xr + j * 256 + lane * 4); ss += v[j][0] * v[j][0] + v[j][1] * v[j][1] + v[j][2] * v[j][2] + v[j][3] * v[j][3]; }
        const float rs = rsqrtf(wave_sum(ss) * (1.0f / D) + 1e-6f);
#pragma unroll
        for (int hf = 0; hf < 2; ++hf) {
            f32x4 g[4], sh[4], scl[4];
#pragma unroll
            for (int jj = 0; jj < 4; ++jj) { const int c0 = (hf * 4 + jj) * 256 + lane * 4; g[jj] = *(const f32x4*)(p.norm_g + l * D + c0); sh[jj] = *(const f32x4*)(md + c0); scl[jj] = *(const f32x4*)(md + 2048 + c0); }
#pragma unroll
            for (int jj = 0; jj < 4; ++jj) {
                const int j = hf * 4 + jj, c0 = j * 256 + lane * 4;
                float o[4];
#pragma unroll
                for (int e = 0; e < 4; ++e) o[e] = v[j][e] * rs * g[jj][e] * (1.0f + scl[jj][e]) + sh[jj][e];
                *(uint2*)(H + (size_t)row * D + c0) = make_uint2(pk2bf(o[0], o[1]), pk2bf(o[2], o[3]));
            }
        }
    }
}

constexpr int BM = 256, BK = 64, HALF = 128, HTB = HALF * BK * 2, GEMM_LDS = 8 * HTB;
DEVI int lds_byte(int r, int c) { const int st = (r >> 4) * 2 + (c >> 5), rr = r & 15, cc = c & 31, ob = rr * 64 + cc * 2; return st * 1024 + (ob ^ (((ob >> 9) & 1) << 5)); }
DEVI void stage_rc(int b, int& R, int& C) { const int st = b / 1024, sb = b % 1024, swz = sb ^ (((sb >> 9) & 1) << 5); R = (st >> 1) * 16 + swz / 64; C = (st & 1) * 32 + (swz % 64) / 2; }
DEVI int perm32(int rho) { const int n = rho >> 4, i = rho & 15; return 8 * (i >> 2) + 4 * n + (i & 3); }
struct Unit { int pm, pn; };
struct StaticOrder {
    int nM, nN, nwg, G, c;
    DEVI void init(int M, int N, int G_, int c_) { nM = M / BM; nN = N / BM; nwg = nM * nN; G = G_; c = c_; }
    DEVI bool next(int i, Unit& u) const {
        const long L = (long)i * G + c; if (L >= nwg) return false;
        int wgid = (int)L; { const int q = nwg / 8, r = nwg % 8, xcd = wgid % 8, off = wgid / 8; wgid = (xcd < r ? xcd * (q + 1) : r * (q + 1) + (xcd - r) * q) + off; }
        const int nig = 8 * nN, gid = wgid / nig, fm = gid * 8, gsz = (nM - fm) < 8 ? (nM - fm) : 8;
        u.pm = fm + ((wgid % nig) % gsz); u.pn = (wgid % nig) / gsz; return true;
    }
};
template <class Epi>
DEVI void gemm_phase(LAS unsigned char* lds, const bf16_t* gA, const bf16_t* gBt, const int K, const StaticOrder& S, const Epi& E) {
    const int tid = TIDX, wid = __builtin_amdgcn_readfirstlane(tid >> 6), lane = tid & 63, wr = wid >> 2, wc = wid & 3, fr = lane & 15, fq = lane >> 4;
    const int nt = K / BK;
    unsigned voffA[2], voffB[2];
#pragma unroll
    for (int i = 0; i < 2; ++i) { int R, C; stage_rc(tid * 16 + i * 8192, R, C); const int Rb = Epi::PERM ? ((R & ~31) + perm32(R & 31)) : R;
        voffA[i] = (unsigned)(R * K + C) * 2u; voffB[i] = (unsigned)(Rb * K + C) * 2u; }
    const size_t kstep = (size_t)(BK * 2), hstep = (size_t)HALF * K * 2, tstep = 2 * hstep;
    const unsigned ldsw = (unsigned)wid * 1024u;
    const int aoff = lds_byte(wr * 64 + fr, fq * 8), boff = lds_byte(wc * 32 + fr, fq * 8);
#define PG8_SA(b, h) (((b) * 2 + (h)) * HTB)
#define PG8_SB(b, h) ((4 + (b) * 2 + (h)) * HTB)
#define PG8_STAGE(bufoff, gbase, voff) do { _Pragma("unroll") for (int _i = 0; _i < 2; ++_i) \
        __builtin_amdgcn_global_load_lds((const unsigned*)((const char*)(gbase) + (voff)[_i]), (LAS unsigned*)(lds + (bufoff) + ldsw + _i * 8192), 16, 0, 0); } while (0)
#define PG8_LDA(dst, b, h) do { _Pragma("unroll") for (int m = 0; m < 4; ++m) _Pragma("unroll") for (int k = 0; k < 2; ++k) dst[m][k] = *(const LAS bf16x8*)(lds + PG8_SA(b, h) + aoff + m * 2048 + k * 1024); } while (0)
#define PG8_LDB(dst, b, h) do { _Pragma("unroll") for (int n = 0; n < 2; ++n) _Pragma("unroll") for (int k = 0; k < 2; ++k) dst[n][k] = *(const LAS bf16x8*)(lds + PG8_SB(b, h) + boff + n * 2048 + k * 1024); } while (0)
#define PG8_MMA(ai, bj, At, Bt) do { __builtin_amdgcn_s_setprio(1); _Pragma("unroll") for (int m = 0; m < 4; ++m) _Pragma("unroll") for (int n = 0; n < 2; ++n) _Pragma("unroll") for (int k = 0; k < 2; ++k) \
        acc[ai][bj][m][n] = __builtin_amdgcn_mfma_f32_16x16x32_bf16(Bt[n][k], At[m][k], acc[ai][bj][m][n], 0, 0, 0); __builtin_amdgcn_s_setprio(0); } while (0)
#define PG8_WAIT_V(n) asm volatile("s_waitcnt vmcnt(" #n ")" ::: "memory")
#define PG8_WAIT_L(n) asm volatile("s_waitcnt lgkmcnt(" #n ")" ::: "memory")
#define PG8_BAR __builtin_amdgcn_s_barrier()
#define PG8_SCHED __builtin_amdgcn_sched_barrier(0)
    Unit cur, nxt; int ui = 0;
    if (!S.next(0, cur)) return;
    f32x4 acc[2][2][4][2];
#pragma unroll
    for (int a = 0; a < 2; ++a)
#pragma unroll
        for (int b = 0; b < 2; ++b)
#pragma unroll
            for (int m = 0; m < 4; ++m)
#pragma unroll
                for (int n = 0; n < 2; ++n) acc[a][b][m][n] = (f32x4){0.f, 0.f, 0.f, 0.f};
    bf16x8 At[4][2], B0[2][2], B1[2][2];
    const char* cA = (const char*)gA + (size_t)cur.pm * tstep; const char* cB = (const char*)gBt + (size_t)cur.pn * tstep;
    PG8_STAGE(PG8_SB(0, 0), cB, voffB); PG8_STAGE(PG8_SB(0, 1), cB + hstep, voffB); PG8_STAGE(PG8_SA(0, 0), cA, voffA); PG8_STAGE(PG8_SA(0, 1), cA + hstep, voffA);
    if (wr == 1) PG8_BAR;
    PG8_WAIT_V(2); PG8_BAR;
    PG8_STAGE(PG8_SB(1, 0), cB + kstep, voffB); PG8_STAGE(PG8_SA(1, 0), cA + kstep, voffA); PG8_STAGE(PG8_SB(1, 1), cB + hstep + kstep, voffB);
    PG8_WAIT_V(6); PG8_BAR;
    for (;;) {
        const bool has_next = S.next(ui + 1, nxt);
        const char* nA = has_next ? (const char*)gA + (size_t)nxt.pm * tstep : cA; const char* nB = has_next ? (const char*)gBt + (size_t)nxt.pn * tstep : cB;
        for (int t = 0; t < nt; t += 2) {
            const bool last = (t == nt - 2);
            const char* a1 = cA + (size_t)(t + 1) * kstep;
            const char* a2 = last ? nA : cA + (size_t)(t + 2) * kstep; const char* b2 = last ? nB : cB + (size_t)(t + 2) * kstep;
            const char* a3 = a2 + kstep; const char* b3 = b2 + kstep;
            PG8_LDB(B0, 0, 0); PG8_LDB(B1, 0, 1); PG8_SCHED; PG8_LDA(At, 0, 0); PG8_STAGE(PG8_SA(1, 1), a1 + hstep, voffA);
            PG8_WAIT_V(8); PG8_WAIT_L(0); PG8_BAR; PG8_MMA(0, 0, At, B0); PG8_MMA(0, 1, At, B1); PG8_BAR; PG8_SCHED;
            PG8_LDA(At, 0, 1); PG8_STAGE(PG8_SB(0, 0), b2, voffB); PG8_STAGE(PG8_SB(0, 1), b2 + hstep, voffB); PG8_STAGE(PG8_SA(0, 0), a2, voffA);
            PG8_WAIT_V(8); PG8_WAIT_L(0); PG8_BAR; PG8_MMA(1, 0, At, B0); PG8_MMA(1, 1, At, B1); PG8_BAR; PG8_SCHED;
            PG8_LDB(B0, 1, 0); PG8_LDB(B1, 1, 1); PG8_SCHED; PG8_LDA(At, 1, 0); PG8_STAGE(PG8_SA(0, 1), a2 + hstep, voffA);
            PG8_WAIT_V(8); PG8_WAIT_L(0); PG8_BAR; PG8_MMA(0, 0, At, B0); PG8_MMA(0, 1, At, B1); PG8_BAR; PG8_SCHED;
            PG8_LDA(At, 1, 1); PG8_STAGE(PG8_SB(1, 0), b3, voffB); PG8_STAGE(PG8_SB(1, 1), b3 + hstep, voffB); PG8_STAGE(PG8_SA(1, 0), a3, voffA);
            PG8_WAIT_V(8); PG8_WAIT_L(0); PG8_BAR; PG8_MMA(1, 0, At, B0); PG8_MMA(1, 1, At, B1); PG8_BAR; PG8_SCHED;
        }
        if (wr == 0) PG8_BAR;
        E(acc, cur, wr, wc, fr, fq);
        if (!has_next) break;
#pragma unroll
        for (int a = 0; a < 2; ++a)
#pragma unroll
            for (int b = 0; b < 2; ++b)
#pragma unroll
                for (int m = 0; m < 4; ++m)
#pragma unroll
                    for (int n = 0; n < 2; ++n) acc[a][b][m][n] = (f32x4){0.f, 0.f, 0.f, 0.f};
        cur = nxt; cA = nA; cB = nB; ++ui;
        if (wr == 1) PG8_BAR;
    }
    PG8_WAIT_V(0);
    PG8_BAR;
}
template <class Epi>
DEVI void gemm_quarter(LAS unsigned char* lds, const bf16_t* gA, const bf16_t* gBt, const int K, const Epi& E) {
    const int tid = TIDX, wid = __builtin_amdgcn_readfirstlane(tid >> 6), lane = tid & 63, wr = wid >> 2, wc = wid & 3, fr = lane & 15, fq = lane >> 4;
    const int nt = K / BK;
    unsigned voff[2];
#pragma unroll
    for (int i = 0; i < 2; ++i) { int R, C; stage_rc(tid * 16 + i * 8192, R, C); voff[i] = (unsigned)(R * K + C) * 2u; }
    const size_t kstep = (size_t)(BK * 2);
    const unsigned ldsw = (unsigned)wid * 1024u;
    const int aoff = lds_byte(wr * 64 + fr, fq * 8), boff = lds_byte(wc * 32 + fr, fq * 8);
    f32x4 acc[1][1][4][2];
#pragma unroll
    for (int m = 0; m < 4; ++m)
#pragma unroll
        for (int n = 0; n < 2; ++n) acc[0][0][m][n] = (f32x4){0.f, 0.f, 0.f, 0.f};
    bf16x8 At[4][2], B0[2][2];
    const char* cA = (const char*)gA; const char* cB = (const char*)gBt;
#define QSTEP(r, tt) do { const int tn_ = ((tt) + 3 < nt) ? (tt) + 3 : nt - 1;     \
        PG8_WAIT_V(8); PG8_BAR; \
        PG8_STAGE(PG8_SB((((r) + 3) & 3) >> 1, ((r) + 3) & 1), cB + (size_t)tn_ * kstep, voff); PG8_STAGE(PG8_SA((((r) + 3) & 3) >> 1, ((r) + 3) & 1), cA + (size_t)tn_ * kstep, voff); \
        PG8_LDB(B0, (r) >> 1, (r) & 1); PG8_LDA(At, (r) >> 1, (r) & 1); PG8_WAIT_L(0); PG8_MMA(0, 0, At, B0); } while (0)
    PG8_STAGE(PG8_SB(0, 0), cB, voff); PG8_STAGE(PG8_SA(0, 0), cA, voff);
    PG8_STAGE(PG8_SB(0, 1), cB + kstep, voff); PG8_STAGE(PG8_SA(0, 1), cA + kstep, voff);
    PG8_STAGE(PG8_SB(1, 0), cB + 2 * kstep, voff); PG8_STAGE(PG8_SA(1, 0), cA + 2 * kstep, voff);
    for (int t = 0; t < nt; t += 4) { QSTEP(0, t); QSTEP(1, t + 1); QSTEP(2, t + 2); QSTEP(3, t + 3); }
#undef QSTEP
    E(acc[0][0], wr, wc, fr, fq);
    PG8_WAIT_V(0);
    PG8_BAR;
}
#undef PG8_SA
#undef PG8_SB
#undef PG8_STAGE
#undef PG8_LDA
#undef PG8_LDB
#undef PG8_MMA
struct EpiIn {
    static constexpr bool PERM = true;
    int l;
    DEVI void operator()(const f32x4 (&acc)[2][2][4][2], const Unit& u, int wr, int wc, int fr, int fq) const {
        KPARAMS(pe); bf16_t* P = (bf16_t*)(pe.ws + WS_P); float* out = pe.out; const float* RC = (const float*)(pe.ws + WS_ROPE);
        const int row0 = u.pm * BM + wr * 64 + fr, col0 = u.pn * BM + wc * 32 + 8 * fq;
        const bool cache = (row0 < MC) && (col0 >= CK) && (col0 < CAG);
        const bool hyt = col0 >= CHV; bf16_t* PHb = (bf16_t*)(pe.ws + WS_PH);
        const bool rope = (row0 >= MC) && (col0 < CV);
        const float* rcb = RC + (wc & 1) * 16 + 8 * (fq & 1); const float sgn = fq < 2 ? -1.f : 1.f;
#pragma unroll
        for (int ai = 0; ai < 2; ++ai)
#pragma unroll
            for (int m = 0; m < 4; ++m) {
                const int row = row0 + ai * HALF + m * 16;
                bf16_t* rowp = hyt ? PHb + ((size_t)((col0 - CHV) >> 3) * MT + row) * 8 : P + (size_t)row * IN_W + col0;
#pragma unroll
                for (int bj = 0; bj < 2; ++bj) {
                    f32x4 v0 = acc[ai][bj][m][0], v1 = acc[ai][bj][m][1];
                    if (rope) {
                        const float* rc = rcb + ((row - MC) & (DSEQ - 1)) * 32;
                        const f32x4 c0 = *(const f32x4*)rc, c1 = *(const f32x4*)(rc + 4), s0 = *(const f32x4*)(rc + 1024 * 32), s1 = *(const f32x4*)(rc + 1024 * 32 + 4);
#pragma unroll
                        for (int e = 0; e < 4; ++e) { const auto q0 = __builtin_amdgcn_permlane32_swap(__float_as_uint(v0[e]), __float_as_uint(v0[e]), false, false), q1 = __builtin_amdgcn_permlane32_swap(__float_as_uint(v1[e]), __float_as_uint(v1[e]), false, false);
                            const float p0 = __uint_as_float(fq < 2 ? q0[1] : q0[0]), p1 = __uint_as_float(fq < 2 ? q1[1] : q1[0]); v0[e] = v0[e] * c0[e] + sgn * p0 * s0[e]; v1[e] = v1[e] * c1[e] + sgn * p1 * s1[e]; }
                    }
                    u32x4 w; w.x = pk2bf(v0[0], v0[1]); w.y = pk2bf(v0[2], v0[3]); w.z = pk2bf(v1[0], v1[1]); w.w = pk2bf(v1[2], v1[3]);
                    *(u32x4*)(rowp + (hyt ? (size_t)(bj * HALF / 8) * MT * 8 : (size_t)(bj * HALF))) = w;
                    if (cache) {
                        const int col = col0 + bj * HALF, which = col >= CV, cc = col - CK - which * 1024, b = row >> 8, t = row & 255;
                        float* o = out + (which ? OUT_V : OUT_K) + ((size_t)(b * 2 + l) * 256 + t) * 1024 + cc;
                        *(f32x4*)o = v0; *(f32x4*)(o + 4) = v1;
                    }
                }
            }
    }
};
struct EpiOut {
    static constexpr bool PERM = false;
    int l;
    DEVI void operator()(const f32x4 (&acc)[2][2][4][2], const Unit& u, int wr, int wc, int fr, int fq) const {
        KPARAMS(pe); const float* xp = pe.x_prompt; const float* xs = pe.x_sample; float* X = pe.out; const float* MOD = (const float*)(pe.ws + WS_MOD);
        const int row0 = u.pm * BM + wr * 64 + fr, col0 = u.pn * BM + wc * 32 + 4 * fq;
        const float* gate = MOD + (size_t)(l * 3 + cond_of_row(u.pm * BM)) * 6144 + 4096 + col0;
        const float* xin = (l == 0) ? (row0 < MC ? xp : xs - (size_t)MC * D) : X;
#pragma unroll
        for (int bj = 0; bj < 2; ++bj)
#pragma unroll
            for (int n = 0; n < 2; ++n) {
                const f32x4 g = *(const f32x4*)(gate + bj * HALF + n * 16);
                f32x4 xv[2][4];
#pragma unroll
                for (int ai = 0; ai < 2; ++ai)
#pragma unroll
                    for (int m = 0; m < 4; ++m) xv[ai][m] = *(const f32x4*)(xin + (size_t)(row0 + ai * HALF + m * 16) * D + col0 + bj * HALF + n * 16);
#pragma unroll
                for (int ai = 0; ai < 2; ++ai)
#pragma unroll
                    for (int m = 0; m < 4; ++m) *(f32x4*)(X + (size_t)(row0 + ai * HALF + m * 16) * D + col0 + bj * HALF + n * 16) = xv[ai][m] + g * acc[ai][bj][m][n];
            }
    }
};
struct EpiOutQ {
    int l, rbase, cbase;
    DEVI void operator()(const f32x4 (&acc)[4][2], int wr, int wc, int fr, int fq) const {
        KPARAMS(pe); const float* xs = pe.x_sample; float* X = pe.out; const float* MOD = (const float*)(pe.ws + WS_MOD);
        const int row0 = rbase + wr * 64 + fr, col0 = cbase + wc * 32 + 4 * fq;
        const float* gate = MOD + (size_t)(l * 3 + cond_of_row(rbase)) * 6144 + 4096 + col0;
        const float* xin = (l == 0) ? xs - (size_t)MC * D : X;
#pragma unroll
        for (int n = 0; n < 2; ++n) {
            const f32x4 g = *(const f32x4*)(gate + n * 16);
            f32x4 xv[4];
#pragma unroll
            for (int m = 0; m < 4; ++m) xv[m] = *(const f32x4*)(xin + (size_t)(row0 + m * 16) * D + col0 + n * 16);
#pragma unroll
            for (int m = 0; m < 4; ++m) *(f32x4*)(X + (size_t)(row0 + m * 16) * D + col0 + n * 16) = xv[m] + g * acc[m][n];
        }
    }
};
DEVI void ph_gemm_in(const Params& p, int l, char* lds) {
    EpiIn e{l};
    StaticOrder S; S.init(MT, IN_W, gridDim.x, blockIdx.x);
    gemm_phase((LAS unsigned char*)lds, (const bf16_t*)(p.ws + WS_H), (const bf16_t*)(p.ws + WS_WINT) + (size_t)l * IN_W * D, D, S, e);
}
DEVI void ph_gemm_out(const Params& p, int l, char* lds) {
    EpiOut e{l};
    StaticOrder S; S.init(MC, D, gridDim.x, blockIdx.x);
    gemm_phase((LAS unsigned char*)lds, (const bf16_t*)(p.ws + WS_MIX), (const bf16_t*)(p.ws + WS_WOUTT) + (size_t)l * D * D, D, S, e);
    for (int q = blockIdx.x; q < (MS / HALF) * (D / HALF); q += gridDim.x) {
        const int x = q & 7, s = (q >> 3) & 31, qm = 4 * (x >> 1) + (s & 3), qn = 8 * (x & 1) + (s >> 2);
        EpiOutQ eq{l, MC + qm * HALF, qn * HALF};
        gemm_quarter((LAS unsigned char*)lds, (const bf16_t*)(p.ws + WS_MIX) + (size_t)(MC + qm * HALF) * D, (const bf16_t*)(p.ws + WS_WOUTT) + (size_t)l * D * D + (size_t)(qn * HALF) * D, D, eq);
    }
}

namespace att {
using s16x4 = __attribute__((ext_vector_type(4))) short;
using f32x16 = __attribute__((ext_vector_type(16))) float;
constexpr int KVBLK = 64, SHM_V = 64 * 128 * 2, SHM_K = 64 * 128 * 2;
constexpr float SCALE = 0.125f, THR = 8.f;
#define KSWZ(row, colB) ((row) * 256 + ((colB) ^ (((row) & 7) << 4)))
#define SBAR() __builtin_amdgcn_sched_barrier(0)
DEVI int crow(int r, int hi) { return (r & 3) + 8 * (r >> 2) + 4 * hi; }
DEVI unsigned cvtpk(float lo, float hi) { unsigned r; asm volatile("v_cvt_pk_bf16_f32 %0, %1, %2" : "=v"(r) : "v"(lo), "v"(hi)); return r; }
DEVI void partialSM(f32x16& p0, f32x16& p1, float& m_reg, float& mn, float& alpha) {
    constexpr float C = SCALE * 1.4426950408889634f;
    float pmax = p0[0];
#pragma unroll
    for (int r = 1; r < 16; ++r) pmax = fmaxf(pmax, p0[r]);
#pragma unroll
    for (int r = 0; r < 16; ++r) pmax = fmaxf(pmax, p1[r]);
    { auto rr = __builtin_amdgcn_permlane32_swap(__float_as_uint(pmax), __float_as_uint(pmax), false, false); pmax = fmaxf(__uint_as_float(rr[0]), __uint_as_float(rr[1])); }
    if (__builtin_expect(__all(pmax - m_reg <= THR / SCALE), 1)) { mn = m_reg; alpha = 1.f; }
    else { mn = fmaxf(m_reg, pmax); alpha = __builtin_amdgcn_exp2f((m_reg - mn) * C); m_reg = mn; }
    const float mnC = -mn * C;
#pragma unroll
    for (int r = 0; r < 16; ++r) p0[r] = fmaf(p0[r], C, mnC);
#pragma unroll
    for (int r = 0; r < 16; ++r) p1[r] = fmaf(p1[r], C, mnC);
#pragma unroll
    for (int r = 0; r < 16; ++r) p0[r] = __builtin_amdgcn_exp2f(p0[r]);
}
DEVI void finishSM(f32x16& p0, f32x16& p1, float alpha, float& l_reg, bf16x8& pa0, bf16x8& pa1, bf16x8& pa2, bf16x8& pa3) {
#pragma unroll
    for (int r = 0; r < 16; ++r) p1[r] = __builtin_amdgcn_exp2f(p1[r]);
    float ps = 0;
#pragma unroll
    for (int r = 0; r < 16; ++r) ps += p0[r];
#pragma unroll
    for (int r = 0; r < 16; ++r) ps += p1[r];
    { auto rr = __builtin_amdgcn_permlane32_swap(__float_as_uint(ps), __float_as_uint(ps), false, false); ps = __uint_as_float(rr[0]) + __uint_as_float(rr[1]); }
    l_reg = l_reg * alpha + ps;
#define PK4(P, BASE, OUT) do { unsigned a0 = cvtpk(P[BASE + 0], P[BASE + 1]), a1 = cvtpk(P[BASE + 2], P[BASE + 3]);   \
    unsigned b0 = cvtpk(P[BASE + 4], P[BASE + 5]), b1 = cvtpk(P[BASE + 6], P[BASE + 7]);                              \
    auto r0 = __builtin_amdgcn_permlane32_swap(a0, b0, false, false); auto r1 = __builtin_amdgcn_permlane32_swap(a1, b1, false, false); \
    u32x4 w = {r0[0], r1[0], r0[1], r1[1]}; OUT = *reinterpret_cast<bf16x8*>(&w); } while (0)
    PK4(p0, 0, pa0); PK4(p0, 8, pa1); PK4(p1, 0, pa2); PK4(p1, 8, pa3);
#undef PK4
}
DEVI void qkt(f32x16& p0, f32x16& p1, const char* Ks, const bf16x8* qr, int r32, int hi, int c) {
    p0 = f32x16{}; p1 = f32x16{};
#pragma unroll
    for (int d0 = 0; d0 < 4; ++d0) { const int cb = ((c * 4 + d0) * 16 + hi * 8) * 2;
        const bf16x8 b0 = *reinterpret_cast<const bf16x8*>(Ks + KSWZ(r32, cb));
        const bf16x8 b1 = *reinterpret_cast<const bf16x8*>(Ks + KSWZ(32 + r32, cb));
        p0 = __builtin_amdgcn_mfma_f32_32x32x16_bf16(b0, qr[d0], p0, 0, 0, 0);
        p1 = __builtin_amdgcn_mfma_f32_32x32x16_bf16(b1, qr[d0], p1, 0, 0, 0); }
}
DEVI int v_st(int k, int c) { const int kk = (k & ~0xC) | ((k & 4) << 1) | ((k & 8) >> 1); return ((kk >> 3) * 4 + (c >> 5)) * 512 + ((kk & 7) * 32 + (c & 31)) * 2; }
DEVI int v_rd_base(int lane) { return ((lane & 3) << 3) | (((lane >> 2) & 3) << 6) | (((lane >> 4) & 1) << 5) | (((lane >> 5) & 1) << 8); }
constexpr int v_rd_off(int d0, int ks, int half) { return d0 * 512 + ks * 4096 + half * 2048; }
template <int OFF> DEVI s16x4 tr_read(int vb) { s16x4 r; asm volatile("ds_read_b64_tr_b16 %0, %1 offset:%2" : "=&v"(r) : "v"(vb), "i"(OFF) : "memory"); return r; }
template <int D0> DEVI void pv_one(f32x16& od, int vb, bf16x8 pa0, bf16x8 pa1, bf16x8 pa2, bf16x8 pa3) {
    const s16x4 l0 = tr_read<v_rd_off(D0, 0, 0)>(vb), h0 = tr_read<v_rd_off(D0, 0, 1)>(vb), l1 = tr_read<v_rd_off(D0, 1, 0)>(vb), h1 = tr_read<v_rd_off(D0, 1, 1)>(vb);
    const s16x4 l2 = tr_read<v_rd_off(D0, 2, 0)>(vb), h2 = tr_read<v_rd_off(D0, 2, 1)>(vb), l3 = tr_read<v_rd_off(D0, 3, 0)>(vb), h3 = tr_read<v_rd_off(D0, 3, 1)>(vb);
    asm volatile("s_waitcnt lgkmcnt(0)" ::: "memory"); SBAR();
#define PK(L, H) (bf16x8){L[0], L[1], L[2], L[3], H[0], H[1], H[2], H[3]}
    od = __builtin_amdgcn_mfma_f32_32x32x16_bf16(pa0, PK(l0, h0), od, 0, 0, 0);
    od = __builtin_amdgcn_mfma_f32_32x32x16_bf16(pa1, PK(l1, h1), od, 0, 0, 0);
    od = __builtin_amdgcn_mfma_f32_32x32x16_bf16(pa2, PK(l2, h2), od, 0, 0, 0);
    od = __builtin_amdgcn_mfma_f32_32x32x16_bf16(pa3, PK(l3, h3), od, 0, 0, 0);
#undef PK
}
DEVI void pv_d0(f32x16* o, int vb, bf16x8 pa0, bf16x8 pa1, bf16x8 pa2, bf16x8 pa3) {
    pv_one<0>(o[0], vb, pa0, pa1, pa2, pa3); pv_one<1>(o[1], vb, pa0, pa1, pa2, pa3); pv_one<2>(o[2], vb, pa0, pa1, pa2, pa3); pv_one<3>(o[3], vb, pa0, pa1, pa2, pa3);
}
DEVI void attn_unit(int l, int unit, char* lds) {
    KPARAMS(p);
    const int tid = TIDX, wid = tid >> 6, lane = tid & 63, r32 = lane & 31, hi = lane >> 5, c = wid >> 2, wq = wid & 3;
    const bf16_t* P = (const bf16_t*)(p.ws + WS_P); const bf16_t* CKB = (const bf16_t*)(p.ws + WS_CKB); const bf16_t* CVB = (const bf16_t*)(p.ws + WS_CVB);
    const bool smp = unit < 128; const int v = unit - 128;
    const int b = smp ? unit >> 6 : v >> 4, h = smp ? (unit >> 3) & 7 : (v >> 1) & 7, qb = smp ? unit & 7 : v & 1;
    const int NTL = smp ? 24 : 4, krow0 = smp ? MC + b * DSEQ : b * SEQ, qrow0 = krow0 + qb * 128;
    char* V_lds = lds; char* K_lds = lds + 2 * SHM_V;
    float* wsm = (float*)(lds + 2 * SHM_V + 2 * SHM_K) + wid * 64; float* li_l = wsm; float* al_l = wsm + 32;
    float m_reg = -1e30f, l_reg = 0; f32x16 o[4] = {}; bf16x8 qr[4];
    { const bf16_t* Qw = P + (size_t)(qrow0 + wq * 32 + r32) * IN_W + CQ + h * 128 + c * 64 + hi * 8;
#pragma unroll
      for (int d0 = 0; d0 < 4; ++d0) qr[d0] = *reinterpret_cast<const bf16x8*>(Qw + d0 * 16); }
    const int sr = tid >> 4, sc = (tid & 15) * 8, vst0 = v_st(sr, sc), vst1 = v_st(32 + sr, sc);
    const int vb0 = (int)(uintptr_t)V_lds + v_rd_base(lane);
    struct { bf16x8 vs0, vs1, ks0, ks1; } sr_[2];
#define KVPTR(j, kp, vp, st) do { if (smp && (j) < 8) { const size_t o_ = ((size_t)((b * 2 + l) * PAST + (j) * 64)) * 1024 + h * 128; kp = CKB + o_; vp = CVB + o_; st = 1024; } \
      else { const size_t o_ = (size_t)(krow0 + ((j) - (smp ? 8 : 0)) * 64) * IN_W + h * 128; kp = P + o_ + CK; vp = P + o_ + CV; st = IN_W; } } while (0)
#define SLOAD(i, j) do { const bf16_t* kp_; const bf16_t* vp_; int st_; KVPTR(j, kp_, vp_, st_); \
      sr_[i].vs0 = *reinterpret_cast<const bf16x8*>(vp_ + (size_t)sr * st_ + sc); sr_[i].vs1 = *reinterpret_cast<const bf16x8*>(vp_ + (size_t)(32 + sr) * st_ + sc); \
      sr_[i].ks0 = *reinterpret_cast<const bf16x8*>(kp_ + (size_t)sr * st_ + sc); sr_[i].ks1 = *reinterpret_cast<const bf16x8*>(kp_ + (size_t)(32 + sr) * st_ + sc); } while (0)
#define SWRITE(bb, i) do { *(bf16x8*)(V_lds + (bb) * SHM_V + vst0) = sr_[i].vs0; *(bf16x8*)(V_lds + (bb) * SHM_V + vst1) = sr_[i].vs1; const int kc = sc * 2; \
      *(bf16x8*)(K_lds + (bb) * SHM_K + KSWZ(sr, kc)) = sr_[i].ks0; *(bf16x8*)(K_lds + (bb) * SHM_K + KSWZ(32 + sr, kc)) = sr_[i].ks1; } while (0)
#define SWAIT() asm volatile("s_waitcnt vmcnt(4)" ::: "memory")
#define RESC(a) do { if (__any((a) < 1.f)) { if (hi == 0) al_l[r32] = (a); asm volatile("s_waitcnt lgkmcnt(0)" ::: "memory"); \
      _Pragma("unroll") for (int d = 0; d < 4; ++d) _Pragma("unroll") for (int r = 0; r < 16; ++r) o[d][r] *= al_l[crow(r, hi)]; } } while (0)
    f32x16 pA0, pA1, pB0, pB1; float mnA, mnB, alA, alB; bf16x8 pa0, pa1, pa2, pa3;
    constexpr int SE = 0, SO = 1;
    SLOAD(SE, 0); asm volatile("s_waitcnt vmcnt(0)" ::: "memory"); SWRITE(0, SE); __syncthreads();
    qkt(pA0, pA1, K_lds, qr, r32, hi, c); partialSM(pA0, pA1, m_reg, mnA, alA);
    SLOAD(SO, 1); if (2 < NTL) SLOAD(SE, 2);
    SWAIT(); SWRITE(1, SO); __syncthreads();
    for (int j = 1; j + 1 < NTL; j += 2) {
        SBAR(); qkt(pB0, pB1, K_lds + SHM_K, qr, r32, hi, c);
        finishSM(pA0, pA1, alA, l_reg, pa0, pa1, pa2, pa3); SBAR();
        SLOAD(SO, j + 2); SBAR();
        pv_d0(o, vb0, pa0, pa1, pa2, pa3); partialSM(pB0, pB1, m_reg, mnB, alB);
        __syncthreads(); SWAIT(); SWRITE(0, SE);
        RESC(alB); __syncthreads();
        SBAR(); qkt(pA0, pA1, K_lds, qr, r32, hi, c);
        finishSM(pB0, pB1, alB, l_reg, pa0, pa1, pa2, pa3); SBAR();
        if (j + 3 < NTL) SLOAD(SE, j + 3); SBAR();
        pv_d0(o, vb0 + SHM_V, pa0, pa1, pa2, pa3); partialSM(pA0, pA1, m_reg, mnA, alA);
        __syncthreads(); SWAIT(); SWRITE(1, SO);
        RESC(alA); __syncthreads();
    }
    SBAR(); qkt(pB0, pB1, K_lds + SHM_K, qr, r32, hi, c);
    finishSM(pA0, pA1, alA, l_reg, pa0, pa1, pa2, pa3); SBAR();
    pv_d0(o, vb0, pa0, pa1, pa2, pa3); partialSM(pB0, pB1, m_reg, mnB, alB);
    __syncthreads(); RESC(alB);
    finishSM(pB0, pB1, alB, l_reg, pa0, pa1, pa2, pa3); SBAR();
    pv_d0(o, vb0 + SHM_V, pa0, pa1, pa2, pa3);
    KPARAMS(pe);
    const int ql = tid >> 2, sg = (tid & 3) * 32; const size_t erow = (size_t)(qrow0 + ql);
    u32x4 ag[4]; f32x4 gv[8];
    { const bf16_t* agp = (const bf16_t*)(pe.ws + WS_P) + erow * IN_W + CAG + h * 128 + sg; const float* gp = pe.subln_g + l * 128 + sg;
#pragma unroll
      for (int q4 = 0; q4 < 4; ++q4) { ag[q4] = *(const u32x4*)(agp + q4 * 8); gv[2 * q4] = *(const f32x4*)(gp + q4 * 8); gv[2 * q4 + 1] = *(const f32x4*)(gp + q4 * 8 + 4); } }
    if (hi == 0) li_l[r32] = l_reg;
    asm volatile("s_waitcnt lgkmcnt(0)" ::: "memory");
    float rli[16];
    const float lamv = (c == 1) ? *(volatile float*)(lds + LDS_QSLOT + 32) : 1.f;
#pragma unroll
    for (int r = 0; r < 16; ++r) rli[r] = __builtin_amdgcn_rcpf(li_l[crow(r, hi)]) * lamv;
    __syncthreads();
    float* X = (float*)lds;
    if (c == 1) {
#pragma unroll
        for (int r = 0; r < 16; ++r)
#pragma unroll
            for (int d0 = 0; d0 < 4; ++d0) X[(wq * 32 + crow(r, hi)) * 132 + d0 * 32 + r32] = o[d0][r] * rli[r];
    }
    __syncthreads();
    if (c == 0) {
#pragma unroll
        for (int r = 0; r < 16; ++r) {
            const int qx = wq * 32 + crow(r, hi);
#pragma unroll
            for (int d0 = 0; d0 < 4; ++d0) X[qx * 132 + d0 * 32 + r32] = o[d0][r] * rli[r] - X[qx * 132 + d0 * 32 + r32];
        }
    }
    __syncthreads();
    {
        int lq = l; asm volatile("" : "+s"(lq));
        const float post = 1.0f - lam_init_of(lq);
        f32x4 xv[8]; float ss = 0.f;
#pragma unroll
        for (int q8 = 0; q8 < 8; ++q8) { xv[q8] = *(const f32x4*)(X + ql * 132 + sg + q8 * 4); ss += xv[q8][0] * xv[q8][0] + xv[q8][1] * xv[q8][1] + xv[q8][2] * xv[q8][2] + xv[q8][3] * xv[q8][3]; }
        ss += swz_xor<1>(ss); ss += swz_xor<2>(ss);
        const float rs = rsqrtf(ss * (1.0f / 128.0f) + 1e-6f) * post;
        bf16_t* mx = (bf16_t*)(pe.ws + WS_MIX) + erow * D + h * 128 + sg;
#pragma unroll
        for (int q4 = 0; q4 < 4; ++q4) {
            const f32x4 x0 = xv[2 * q4], x1 = xv[2 * q4 + 1], g0 = gv[2 * q4], g1 = gv[2 * q4 + 1];
            float ov[8];
#pragma unroll
            for (int e = 0; e < 4; ++e) { const float a0 = __uint_as_float(ag[q4][e] << 16), a1 = __uint_as_float(ag[q4][e] & 0xffff0000u);
                const float xa = (e < 2 ? x0[2 * e] : x1[2 * e - 4]), xb = (e < 2 ? x0[2 * e + 1] : x1[2 * e - 3]), ga = (e < 2 ? g0[2 * e] : g1[2 * e - 4]), gb = (e < 2 ? g0[2 * e + 1] : g1[2 * e - 3]);
                ov[2 * e] = xa * rs * ga * (a0 * lru_fsig(a0)); ov[2 * e + 1] = xb * rs * gb * (a1 * lru_fsig(a1)); }
            u32x4 w; w.x = pk2bf(ov[0], ov[1]); w.y = pk2bf(ov[2], ov[3]); w.z = pk2bf(ov[4], ov[5]); w.w = pk2bf(ov[6], ov[7]);
            *(u32x4*)(mx + q4 * 8) = w;
        }
    }
    __syncthreads();
#undef KVPTR
#undef SLOAD
#undef SWRITE
#undef SWAIT
#undef RESC
}
}
DEVI void ph_final(const Params& p) {
    const int wid = TIDX >> 6, lane = TIDX & 63, gw = blockIdx.x * (NT / 64) + wid, NGW = gridDim.x * (NT / 64);
    for (int row = gw; row < MT; row += NGW) {
        float* xr = p.out + (size_t)row * D;
        f32x4 v[8]; float ss = 0.f;
#pragma unroll
        for (int j = 0; j < 8; ++j) { v[j] = *(const f32x4*)(xr + j * 256 + lane * 4); ss += v[j][0] * v[j][0] + v[j][1] * v[j][1] + v[j][2] * v[j][2] + v[j][3] * v[j][3]; }
        const float rs = rsqrtf(wave_sum(ss) * (1.0f / D) + 1e-6f);
        f32x4 g[8];
#pragma unroll
        for (int j = 0; j < 8; ++j) g[j] = *(const f32x4*)(p.final_g + j * 256 + lane * 4);
#pragma unroll
        for (int j = 0; j < 8; ++j) *(f32x4*)(xr + j * 256 + lane * 4) = v[j] * rs * g[j];
    }
}

namespace lru {
#define LBAR() do { asm volatile("s_waitcnt lgkmcnt(0)" ::: "memory"); __builtin_amdgcn_s_barrier(); asm volatile("" ::: "memory"); } while (0)
constexpr int L_W = 0, L_XCB = 36864, L_XCF = L_XCB + 9216, L_A = L_XCF + 64 * 68 * 4, L_B = L_A + 64 * 68 * 4, L_SEG = L_B + 64 * 68 * 4, L_C = L_SEG + 4096, L_END = L_C + 512;
DEVI float fsigmoid(float x) { return __builtin_amdgcn_rcpf(1.0f + __builtin_amdgcn_exp2f(-1.4426950408889634f * x)); }
DEVI void gate_ab(float ra, float ia, float sp8, float xc, float& a, float& bb) {
    const float r = fsigmoid(ra), ig = fsigmoid(ia), log_a = sp8 * r, x = 2.0f * log_a;
    a = __builtin_amdgcn_exp2f(1.4426950408889634f * log_a);
    const float poly = -x * (1.0f + x * (0.5f + x * (0.16666667f + x * (0.041666668f + x * 0.0083333333f))));
    const float om = (x > -0.3f) ? poly : 1.0f - __builtin_amdgcn_exp2f(1.4426950408889634f * x);
    bb = __builtin_amdgcn_sqrtf(om) * (ig * xc);
}
template <bool REV> DEVI void scan_chunk(float* AL, float* BL, float* SEG, float* Cc, int ci, int sch, int seg) {
    float av[8], bv[8];
    { float A = 1.f, H = 0.f;
#pragma unroll
      for (int k = 0; k < 8; ++k) { const int pos = seg * 8 + k, tk = REV ? 63 - pos : pos; av[k] = AL[tk * 68 + sch]; bv[k] = BL[tk * 68 + sch]; H = av[k] * H + bv[k]; A *= av[k]; }
      SEG[(seg * 64 + sch) * 2] = A; SEG[(seg * 64 + sch) * 2 + 1] = H; }
    LBAR();
    float h = Cc[(ci & 1) * 64 + sch];
    for (int s2 = 0; s2 < seg; ++s2) h = SEG[(s2 * 64 + sch) * 2] * h + SEG[(s2 * 64 + sch) * 2 + 1];
#pragma unroll
    for (int k = 0; k < 8; ++k) { const int pos = seg * 8 + k, tk = REV ? 63 - pos : pos; h = av[k] * h + bv[k]; BL[tk * 68 + sch] = h; }
    if (seg == 7) Cc[((ci + 1) & 1) * 64 + sch] = h;
    LBAR();
}
DEVI void lru_unit(int l, int unit, char* lds) {
    KPARAMS(p);
    const int tid = TIDX, wid = tid >> 6, lane = tid & 63;
    const bool smp = unit < 16; const int v = unit - 16;
    const int b = smp ? unit >> 3 : v >> 3, n = smp ? unit & 7 : v & 7, L = smp ? DSEQ : SEQ, row0 = smp ? MC + b * DSEQ : b * SEQ, nchunk = L / 64;
    const bf16_t* P = (const bf16_t*)(p.ws + WS_P); bf16_t* MIX = (bf16_t*)(p.ws + WS_MIX);
    float* HS = (float*)(p.ws + WS_HS); float* SA = (float*)(p.ws + WS_SA); float* SB = (float*)(p.ws + WS_SB);
    bf16_t* Wl = (bf16_t*)(lds + L_W); bf16_t* XCB = (bf16_t*)(lds + L_XCB); float* XCF = (float*)(lds + L_XCF);
    float* AL = (float*)(lds + L_A); float* BL = (float*)(lds + L_B); float* SEG = (float*)(lds + L_SEG); float* Cc = (float*)(lds + L_C);
    __syncthreads();
    {
        const bf16_t* src = (const bf16_t*)(p.ws + WS_WGB) + (size_t)(l * 8 + n) * 16384;
#pragma unroll
        for (int i = 0; i < 4; ++i) { const int e = (i * 512 + tid) * 8, mat = e >> 12, d = (e >> 6) & 63, c = e & 63;
            *(u32x4*)(Wl + (mat * 64 + d) * 72 + c) = *(const u32x4*)(src + e); }
    }
    const int ct = tid >> 3, c8 = (tid & 7) * 8, chg = n * 64 + c8;
    const int db = wid & 3, mh = wid >> 2, fr = lane & 15, fq = lane >> 4, gd = db * 16 + fr, gch = n * 64 + gd;
    const int sch = tid & 63, seg = tid >> 6;
    if (tid < 64) Cc[tid] = smp ? p.state_lru[((b * 2 + l) * 2 + 0) * 512 + n * 64 + tid] : 0.f;
    float bav[2], biv[2], sp8[2];
#pragma unroll
    for (int dir = 0; dir < 2; ++dir) { bav[dir] = p.lru_ba[(l * 2 + dir) * 512 + gch]; biv[dir] = p.lru_bi[(l * 2 + dir) * 512 + gch]; sp8[dir] = -8.0f * log1pf(expf(-p.lru_lam[(l * 2 + dir) * 512 + gch])); }
    f32x4 cw0[4], cw1[4], cb0, cb1;
#pragma unroll
    for (int j = 0; j < 4; ++j) { cw0[j] = *(const f32x4*)(p.lru_conv_w + (l * 4 + j) * 512 + chg); cw1[j] = *(const f32x4*)(p.lru_conv_w + (l * 4 + j) * 512 + chg + 4); }
    cb0 = *(const f32x4*)(p.lru_conv_b + l * 512 + chg); cb1 = *(const f32x4*)(p.lru_conv_b + l * 512 + chg + 4);
    u32x4 xv[4], xn[4];
#define LX_LOAD(dst, tbase) do { _Pragma("unroll") for (int j = 0; j < 4; ++j) { const int tt = (tbase) + ct + j - 2; dst[j] = (u32x4){0u, 0u, 0u, 0u}; \
        if (tt >= 0 && tt < L) dst[j] = *(const u32x4*)(P + (size_t)(row0 + tt) * IN_W + CLX + chg); } } while (0)
    LX_LOAD(xv, 0);
#pragma unroll 1
    for (int ci = 0; ci < nchunk; ++ci) {
        const int t0 = ci * 64;
        if (ci + 1 < nchunk) LX_LOAD(xn, t0 + 64);
        {
            float xc[8];
#pragma unroll
            for (int e = 0; e < 4; ++e) { xc[e] = cb0[e]; xc[4 + e] = cb1[e]; }
#pragma unroll
            for (int j = 0; j < 4; ++j) {
#pragma unroll
                for (int e = 0; e < 4; ++e) { const unsigned wd = xv[j][e]; xc[2 * e] += (e < 2 ? cw0[j][2 * e] : cw1[j][2 * e - 4]) * __uint_as_float(wd << 16); xc[2 * e + 1] += (e < 2 ? cw0[j][2 * e + 1] : cw1[j][2 * e - 3]) * __uint_as_float(wd & 0xffff0000u); }
            }
            *(f32x4*)(XCF + ct * 68 + c8) = (f32x4){xc[0], xc[1], xc[2], xc[3]}; *(f32x4*)(XCF + ct * 68 + c8 + 4) = (f32x4){xc[4], xc[5], xc[6], xc[7]};
            u32x4 w; w.x = pk2bf(xc[0], xc[1]); w.y = pk2bf(xc[2], xc[3]); w.z = pk2bf(xc[4], xc[5]); w.w = pk2bf(xc[6], xc[7]);
            *(u32x4*)(XCB + ct * 72 + c8) = w;
        }
        LBAR();
        {
            f32x4 acc[2][4];
#pragma unroll
            for (int mt = 0; mt < 2; ++mt)
#pragma unroll
                for (int g = 0; g < 4; ++g) acc[mt][g] = (f32x4){0.f, 0.f, 0.f, 0.f};
#pragma unroll
            for (int ks = 0; ks < 2; ++ks) {
                bf16x8 af[2], bfr[4];
#pragma unroll
                for (int mt = 0; mt < 2; ++mt) af[mt] = *(const bf16x8*)(XCB + (mh * 32 + mt * 16 + fr) * 72 + ks * 32 + fq * 8);
#pragma unroll
                for (int g = 0; g < 4; ++g) bfr[g] = *(const bf16x8*)(Wl + (g * 64 + gd) * 72 + ks * 32 + fq * 8);
#pragma unroll
                for (int mt = 0; mt < 2; ++mt)
#pragma unroll
                    for (int g = 0; g < 4; ++g) acc[mt][g] = __builtin_amdgcn_mfma_f32_16x16x32_bf16(af[mt], bfr[g], acc[mt][g], 0, 0, 0);
            }
#pragma unroll
            for (int mt = 0; mt < 2; ++mt)
#pragma unroll
                for (int j = 0; j < 4; ++j) {
                    const int tk = mh * 32 + mt * 16 + fq * 4 + j; const float xc = XCF[tk * 68 + gd];
                    float a, bb;
                    gate_ab(acc[mt][0][j] + bav[0], acc[mt][1][j] + biv[0], sp8[0], xc, a, bb);
                    AL[tk * 68 + gd] = a; BL[tk * 68 + gd] = bb;
                    gate_ab(acc[mt][2][j] + bav[1], acc[mt][3][j] + biv[1], sp8[1], xc, a, bb);
                    const size_t gi = (size_t)(row0 + t0 + tk) * 512 + gch; SA[gi] = a; SB[gi] = bb;
                }
        }
        LBAR();
        scan_chunk<false>(AL, BL, SEG, Cc, ci, sch, seg);
        {
            float* hs = HS + (size_t)(row0 + t0 + ct) * 512 + chg;
            *(f32x4*)hs = *(const f32x4*)(BL + ct * 68 + c8); *(f32x4*)(hs + 4) = *(const f32x4*)(BL + ct * 68 + c8 + 4);
        }
#pragma unroll
        for (int j = 0; j < 4; ++j) xv[j] = xn[j];
    }
#undef LX_LOAD
    __syncthreads();
    if (tid < 64) {
        if (!smp) p.out[OUT_ST + ((size_t)(b * 2 + l) * 2 + 0) * 512 + n * 64 + tid] = Cc[(nchunk & 1) * 64 + tid];
        Cc[tid] = smp ? p.state_lru[((b * 2 + l) * 2 + 1) * 512 + n * 64 + tid] : 0.f;
    }
    asm volatile("s_waitcnt vmcnt(0)" ::: "memory");
    __syncthreads();
    f32x4 qa[2], qb[2], qh[2], na[2], nb_[2], nh[2]; u32x4 qg, ng;
#define P2_LOAD(A_, B_, H_, G_, chunk_) do { const size_t r_ = (size_t)(row0 + (chunk_) * 64 + ct); const float* sa_ = SA + r_ * 512 + chg; const float* sb_ = SB + r_ * 512 + chg; const float* hs_ = HS + r_ * 512 + chg; \
        A_[0] = *(const f32x4*)sa_; A_[1] = *(const f32x4*)(sa_ + 4); B_[0] = *(const f32x4*)sb_; B_[1] = *(const f32x4*)(sb_ + 4); H_[0] = *(const f32x4*)hs_; H_[1] = *(const f32x4*)(hs_ + 4); \
        G_ = *(const u32x4*)(P + r_ * IN_W + CLG + chg); } while (0)
    P2_LOAD(qa, qb, qh, qg, nchunk - 1);
#pragma unroll 1
    for (int ci = 0; ci < nchunk; ++ci) {
        const int t0 = (nchunk - 1 - ci) * 64; const size_t row = (size_t)(row0 + t0 + ct);
        if (ci + 1 < nchunk) P2_LOAD(na, nb_, nh, ng, nchunk - 2 - ci);
        *(f32x4*)(AL + ct * 68 + c8) = qa[0]; *(f32x4*)(AL + ct * 68 + c8 + 4) = qa[1];
        *(f32x4*)(BL + ct * 68 + c8) = qb[0]; *(f32x4*)(BL + ct * 68 + c8 + 4) = qb[1];
        LBAR();
        scan_chunk<true>(AL, BL, SEG, Cc, ci, sch, seg);
        {
            const f32x4 h0 = *(const f32x4*)(BL + ct * 68 + c8), h1 = *(const f32x4*)(BL + ct * 68 + c8 + 4);
            float o[8];
#pragma unroll
            for (int e = 0; e < 4; ++e) { const float s0 = (e < 2 ? qh[0][2 * e] + h0[2 * e] : qh[1][2 * e - 4] + h1[2 * e - 4]), s1 = (e < 2 ? qh[0][2 * e + 1] + h0[2 * e + 1] : qh[1][2 * e - 3] + h1[2 * e - 3]);
                const float g0 = __uint_as_float(qg[e] << 16), g1 = __uint_as_float(qg[e] & 0xffff0000u);
                o[2 * e] = s0 * g0 * fsigmoid(g0); o[2 * e + 1] = s1 * g1 * fsigmoid(g1); }
            u32x4 w; w.x = pk2bf(o[0], o[1]); w.y = pk2bf(o[2], o[3]); w.z = pk2bf(o[4], o[5]); w.w = pk2bf(o[6], o[7]);
            *(u32x4*)(MIX + row * D + 1024 + chg) = w;
        }
        LBAR();
#pragma unroll
        for (int e = 0; e < 2; ++e) { qa[e] = na[e]; qb[e] = nb_[e]; qh[e] = nh[e]; }
        qg = ng;
    }
#undef P2_LOAD
    if (!smp && tid < 64) p.out[OUT_ST + ((size_t)(b * 2 + l) * 2 + 1) * 512 + n * 64 + tid] = Cc[(nchunk & 1) * 64 + tid];
    __syncthreads();
}
}

namespace hy {
constexpr int L_ZERO = 36864, L_YT = 40960, L_R = 110592;
template <bool SMP> DEVI void hy_unit_t(int l, int unit, char* lds) {
    constexpr int NCH = SMP ? 4 : 8, NSEQ = SMP ? 2 : 8, L = SMP ? DSEQ : SEQ, NBLK = L / 32, SEQSTRIDE = L * 2 + (L >> 7) * 16;
    KPARAMS(p);
    const int tid = TIDX, wid = tid >> 6, lane = tid & 63, r32 = lane & 31, hi = lane >> 5;
    const int c0 = SMP ? unit * 4 : (unit >> 2) * 8, row0 = SMP ? MC : (unit & 3) * 2048;
    const bf16_t* PHY = (const bf16_t*)(p.ws + WS_PH); bf16_t* MIX = (bf16_t*)(p.ws + WS_MIX);
    char* VT = lds; float* Yt = (float*)(lds + L_YT);
    const int tok0 = tid * 4, sq = tok0 / L, s0 = tok0 % L;
    __syncthreads();
    if (tid < 4) ((unsigned*)(lds + L_ZERO))[tid] = 0u;
    {
        const bf16_t* GSu = (const bf16_t*)(p.ws + WS_GS) + (size_t)l * GS_PER_LAYER + (SMP ? GS_L256 : 0) + (size_t)c0 * 2 * L;
#pragma unroll
        for (int q = 0; q < (NCH * 2 * L / 8) / NT; ++q) *(u32x4*)(lds + L_R + (q * NT + tid) * 16) = *(const u32x4*)(GSu + (size_t)(q * NT + tid) * 8);
    }
    {
        float xh[6][NCH], x1[6][NCH];
#pragma unroll
        for (int rr = 0; rr < 6; ++rr) {
            const int ss = s0 + rr - 1; const bool ok = ss >= 0 && ss < L;
            const bf16_t* src = PHY + ((size_t)(c0 >> 3) * MT + (row0 + tok0 + rr - 1)) * 8 + (c0 & 7);
            constexpr size_t KIND = (size_t)64 * MT * 8;
            if (SMP) { uint2 a = make_uint2(0u, 0u), b = a; if (ok) { a = *(const uint2*)src; b = *(const uint2*)(src + KIND); }
                xh[rr][0] = __uint_as_float(a.x << 16); xh[rr][1] = __uint_as_float(a.x & 0xffff0000u); xh[rr][2] = __uint_as_float(a.y << 16); xh[rr][3] = __uint_as_float(a.y & 0xffff0000u);
                x1[rr][0] = __uint_as_float(b.x << 16); x1[rr][1] = __uint_as_float(b.x & 0xffff0000u); x1[rr][2] = __uint_as_float(b.y << 16); x1[rr][3] = __uint_as_float(b.y & 0xffff0000u); }
            else { u32x4 a = {0u, 0u, 0u, 0u}, b = a; if (ok) { a = *(const u32x4*)src; b = *(const u32x4*)(src + KIND); }
#pragma unroll
                for (int e = 0; e < 4; ++e) { xh[rr][2 * e] = __uint_as_float(a[e] << 16); xh[rr][2 * e + 1] = __uint_as_float(a[e] & 0xffff0000u); x1[rr][2 * e] = __uint_as_float(b[e] << 16); x1[rr][2 * e + 1] = __uint_as_float(b[e] & 0xffff0000u); } }
        }
#pragma unroll
        for (int c = 0; c < NCH; ++c) {
            const int ch = c0 + c;
            const float bh = p.hy_conv_b[l * 1536 + ch], b1 = p.hy_conv_b[l * 1536 + 512 + ch];
            const float wh0 = p.hy_conv_w[(l * 3 + 0) * 1536 + ch], wh1 = p.hy_conv_w[(l * 3 + 1) * 1536 + ch], wh2 = p.hy_conv_w[(l * 3 + 2) * 1536 + ch];
            const float w10 = p.hy_conv_w[(l * 3 + 0) * 1536 + 512 + ch], w11 = p.hy_conv_w[(l * 3 + 1) * 1536 + 512 + ch], w12 = p.hy_conv_w[(l * 3 + 2) * 1536 + 512 + ch];
            float v[4];
#pragma unroll
            for (int e = 0; e < 4; ++e) v[e] = (bh + wh0 * xh[e][c] + wh1 * xh[e + 1][c] + wh2 * xh[e + 2][c]) * (b1 + w10 * x1[e][c] + w11 * x1[e + 1][c] + w12 * x1[e + 2][c]);
            *(uint2*)(VT + (c * NSEQ + sq) * SEQSTRIDE + s0 * 2 + (s0 >> 7) * 16) = make_uint2(pk2bf(v[0], v[1]), pk2bf(v[2], v[3]));
        }
    }
    __syncthreads();
    typedef typename std::conditional<SMP, uint2, u32x4>::type raw_t;
    raw_t xr[6], gr[4];
#pragma unroll
    for (int rr = 0; rr < 6; ++rr) { const int ss = s0 + rr - 1; xr[rr] = raw_t{}; if (ss >= 0 && ss < L) xr[rr] = *(const raw_t*)(PHY + ((size_t)(128 + (c0 >> 3)) * MT + (row0 + tok0 + rr - 1)) * 8 + (c0 & 7)); }
#pragma unroll
    for (int e = 0; e < 4; ++e) gr[e] = *(const raw_t*)(PHY + ((size_t)(192 + (c0 >> 3)) * MT + (row0 + tok0 + e)) * 8 + (c0 & 7));
    {
        const int wch = SMP ? wid >> 1 : wid;
        const unsigned* Rd = (const unsigned*)(lds + L_R) + wch * L;
        constexpr int NTW = SMP ? 1 : 2;
        att::f32x16 acc[NTW];
#pragma unroll
        for (int nt = 0; nt < NTW; ++nt) acc[nt] = att::f32x16{};
        int vbase[NTW], iblk[NTW];
#pragma unroll
        for (int nt = 0; nt < NTW; ++nt) {
            const int colg = SMP ? (wid & 1) * 32 + r32 : nt * 32 + r32, seq = SMP ? colg >> 5 : colg >> 3;
            iblk[nt] = SMP ? colg & 31 : colg & 7; vbase[nt] = (wch * NSEQ + seq) * SEQSTRIDE + hi * 16;
        }
        const int abase = L - 1 - r32 + 8 * hi;
        const unsigned ash = (unsigned)(abase & 1) * 16u;
#pragma unroll 4
        for (int k = -(NBLK - 1); k <= NBLK - 1; ++k) {
#pragma unroll
            for (int ks = 0; ks < 2; ++ks) {
                const unsigned* dp = Rd + ((abase - 32 * k + 16 * ks) >> 1);
                const unsigned d0 = dp[0], d1 = dp[1], d2 = dp[2], d3 = dp[3], d4 = dp[4];
                u32x4 aw; aw.x = __builtin_amdgcn_alignbit(d1, d0, ash); aw.y = __builtin_amdgcn_alignbit(d2, d1, ash); aw.z = __builtin_amdgcn_alignbit(d3, d2, ash); aw.w = __builtin_amdgcn_alignbit(d4, d3, ash);
                const bf16x8 A = __builtin_bit_cast(bf16x8, aw);
#pragma unroll
                for (int nt = 0; nt < NTW; ++nt) {
                    const int src = iblk[nt] - k; const bool ok = src >= 0 && src < NBLK;
                    const int sidx = 32 * src + 16 * ks;
                    const int off = ok ? vbase[nt] + sidx * 2 + (sidx >> 7) * 16 : L_ZERO;
                    const bf16x8 B = *(const bf16x8*)(lds + off);
                    acc[nt] = __builtin_amdgcn_mfma_f32_32x32x16_bf16(A, B, acc[nt], 0, 0, 0);
                }
            }
        }
#pragma unroll
        for (int nt = 0; nt < NTW; ++nt) {
            const int colg = SMP ? (wid & 1) * 32 + r32 : nt * 32 + r32;
#pragma unroll
            for (int r = 0; r < 16; ++r) Yt[(wch * 64 + colg) * 33 + att::crow(r, hi)] = acc[nt][r];
        }
    }
    __syncthreads();
    {
        float x0[6][NCH];
#pragma unroll
        for (int rr = 0; rr < 6; ++rr) {
            if constexpr (SMP) { const uint2 a = xr[rr];
                x0[rr][0] = __uint_as_float(a.x << 16); x0[rr][1] = __uint_as_float(a.x & 0xffff0000u); x0[rr][2] = __uint_as_float(a.y << 16); x0[rr][3] = __uint_as_float(a.y & 0xffff0000u); }
            else { const u32x4 a = xr[rr];
#pragma unroll
                for (int e = 0; e < 4; ++e) { x0[rr][2 * e] = __uint_as_float(a[e] << 16); x0[rr][2 * e + 1] = __uint_as_float(a[e] & 0xffff0000u); } }
        }
        float w0[NCH], w1[NCH], w2[NCH], bb[NCH];
#pragma unroll
        for (int c = 0; c < NCH; ++c) { const int ch = 1024 + c0 + c; bb[c] = p.hy_conv_b[l * 1536 + ch]; w0[c] = p.hy_conv_w[(l * 3 + 0) * 1536 + ch]; w1[c] = p.hy_conv_w[(l * 3 + 1) * 1536 + ch]; w2[c] = p.hy_conv_w[(l * 3 + 2) * 1536 + ch]; }
        const int blk = tok0 >> 5, a0 = tok0 & 31;
#pragma unroll
        for (int e = 0; e < 4; ++e) {
            const size_t row = (size_t)(row0 + tok0 + e);
            float o[NCH];
            if constexpr (SMP) { const uint2 g = gr[e]; const float hg[4] = {__uint_as_float(g.x << 16), __uint_as_float(g.x & 0xffff0000u), __uint_as_float(g.y << 16), __uint_as_float(g.y & 0xffff0000u)};
#pragma unroll
                for (int c = 0; c < NCH; ++c) o[c] = (bb[c] + w0[c] * x0[e][c] + w1[c] * x0[e + 1][c] + w2[c] * x0[e + 2][c]) * Yt[(c * 64 + blk) * 33 + a0 + e] * (hg[c] * lru::fsigmoid(hg[c]));
                *(uint2*)(MIX + row * D + 1536 + c0) = make_uint2(pk2bf(o[0], o[1]), pk2bf(o[2], o[3])); }
            else { const u32x4 g = gr[e];
#pragma unroll
                for (int c = 0; c < NCH; ++c) { const float hg = (c & 1) ? __uint_as_float(g[c >> 1] & 0xffff0000u) : __uint_as_float(g[c >> 1] << 16);
                    o[c] = (bb[c] + w0[c] * x0[e][c] + w1[c] * x0[e + 1][c] + w2[c] * x0[e + 2][c]) * Yt[(c * 64 + blk) * 33 + a0 + e] * (hg * lru::fsigmoid(hg)); }
                u32x4 w; w.x = pk2bf(o[0], o[1]); w.y = pk2bf(o[2], o[3]); w.z = pk2bf(o[4], o[5]); w.w = pk2bf(o[6], o[7]);
                *(u32x4*)(MIX + row * D + 1536 + c0) = w; }
        }
    }
}
DEVI void hy_unit(int l, int unit, char* lds) { if (unit < 128) hy_unit_t<true>(l, unit, lds); else hy_unit_t<false>(l, unit - 128, lds); }
}

constexpr int Q_N0 = 640, Q_N1 = 272, Q_N2 = 384;
DEVI void ph_mix(const Params& p, int l, char* lds) {
    const int tid = TIDX, lane = tid & 63;
    const float d1 = wave_sum(p.lam_q1[l * 64 + lane] * p.lam_k1[l * 64 + lane]), d2 = wave_sum(p.lam_q2[l * 64 + lane] * p.lam_k2[l * 64 + lane]);
    if (tid == 0) *(volatile float*)(lds + LDS_QSLOT + 32) = expf(d1) - expf(d2) + lam_init_of(l);
    unsigned* qctr = (unsigned*)(p.ws + WS_CTL) + 1024 + 256 * l;
    volatile int* slot = (volatile int*)(lds + LDS_QSLOT);
    const int pos = (int)(blockIdx.x >> 3);
    int type = pos < 18 ? 0 : (pos < 26 ? 1 : 2), tries = 0;
    for (;;) {
        const int nq = type == 0 ? Q_N0 : (type == 1 ? Q_N1 : Q_N2);
        __syncthreads();
        if (tid == 0) *slot = (int)__hip_atomic_fetch_add(qctr + 64 * type, 1u, __ATOMIC_RELAXED, __HIP_MEMORY_SCOPE_AGENT);
        __syncthreads();
        const int it = __builtin_amdgcn_readfirstlane(*slot);
        if (it >= nq) { if (++tries == 3) break; type = type == 2 ? 0 : type + 1; continue; }
        if (type == 0) att::attn_unit(l, it, lds);
        else if (type == 1) lru::lru_unit(l, it, lds);
        else hy::hy_unit(l, it, lds);
    }
}

#define XB_TMO      128
#define XB_XCNT(j)  (256  + 64 * (j))
#define XB_XSUB(j)  (1280 + 64 * (j))
#define XB_XGEN(j)  (2304 + 64 * (j))
#define XB_TOP      3328
#define XB_TOPGEN   3392
#define XCD_BAR_WORDS 3456
#define XB_SPIN_CAP (1u << 18)
DEVI unsigned xb_ld(unsigned* p)              { return __hip_atomic_load(p, __ATOMIC_RELAXED, __HIP_MEMORY_SCOPE_AGENT); }
DEVI unsigned xb_add(unsigned* p, unsigned v) { return __hip_atomic_fetch_add(p, v, __ATOMIC_RELAXED, __HIP_MEMORY_SCOPE_AGENT); }
DEVI unsigned xb_xcc_id() { return (unsigned)__builtin_amdgcn_s_getreg((3 << 11) | 20) & 0xFu; }
#define XB_SPIN(cond, bar) do { unsigned _sp = 0; while (cond) { __builtin_amdgcn_s_sleep(1); \
    if ((++_sp & 255u) == 0u) { if (xb_ld(&(bar)[XB_TMO])) break; if (_sp > XB_SPIN_CAP) { atomicAdd(&(bar)[XB_TMO], 1u); break; } } } } while (0)
struct XcdBarrier { unsigned* bar; unsigned x; volatile LAS unsigned* st; };
DEVI XcdBarrier xcd_barrier_post(unsigned* bar, volatile LAS unsigned* st) {
    XcdBarrier b; b.bar = bar; b.x = xb_xcc_id(); b.st = st;
    if (threadIdx.x == 0) (void)xb_add(&bar[XB_XCNT(b.x)], 1u);
    return b;
}
DEVI void xcd_barrier_complete(unsigned* bar, unsigned x, unsigned& nloc, unsigned& nx) {
    const unsigned G = gridDim.x * gridDim.y * gridDim.z;
    unsigned sum, cnt, mine, sp = 0u;
    for (;;) {
        sum = 0u; cnt = 0u; mine = 0u;
#pragma unroll
        for (unsigned j = 0; j < 16; ++j) { const unsigned c = xb_ld(&bar[XB_XCNT(j)]); sum += c; cnt += (c > 0u) ? 1u : 0u; mine = (j == x) ? c : mine; }
        if (sum == G) break;
        __builtin_amdgcn_s_sleep(1);
        if ((++sp & 255u) == 0u) { if (xb_ld(&bar[XB_TMO])) break; if (sp > XB_SPIN_CAP) { atomicAdd(&bar[XB_TMO], 1u); break; } }
    }
    nloc = mine > 0u ? mine : 1u; nx = cnt > 0u ? cnt : 1u;
}
DEVI void xcd_barrier(const XcdBarrier& b) {
    asm volatile("s_waitcnt vmcnt(0)" ::: "memory");
    __syncthreads();
    if (threadIdx.x == 0) {
        unsigned* bar = b.bar;
        __builtin_amdgcn_s_waitcnt(0);
        unsigned nloc = b.st[0], nx = b.st[1];
        if (nloc == 0u) { xcd_barrier_complete(bar, b.x, nloc, nx); b.st[0] = nloc; b.st[1] = nx; }
        const unsigned old = xb_add(&bar[XB_XSUB(b.x)], 1u);
        const unsigned gen = old / nloc;
        if (old + 1u == (gen + 1u) * nloc) {
            __builtin_amdgcn_fence(__ATOMIC_RELEASE, "agent");
            asm volatile("s_waitcnt vmcnt(0)" ::: "memory");
            const unsigned og = xb_add(&bar[XB_TOP], 1u);
            const unsigned tg = og / nx;
            if (og + 1u == (tg + 1u) * nx) xb_add(&bar[XB_TOPGEN], 1u);
            else XB_SPIN(xb_ld(&bar[XB_TOPGEN]) == tg, bar);
            __builtin_amdgcn_fence(__ATOMIC_ACQUIRE, "agent");
            xb_add(&bar[XB_XGEN(b.x)], 1u);
            asm volatile("s_waitcnt vmcnt(0)" ::: "memory");
        } else {
            XB_SPIN(xb_ld(&bar[XB_XGEN(b.x)]) == gen, bar);
            __builtin_amdgcn_fence(__ATOMIC_ACQUIRE, "agent");
            asm volatile("s_waitcnt vmcnt(0)" ::: "memory");
        }
    }
    __syncthreads();
}

#if defined(__HIP_DEVICE_COMPILE__)
#define PH(call) do { const Params p = *kparams(); call; } while (0)
#else
#define PH(call) do { const Params& p = p_; call; } while (0)
#endif
__global__ void __launch_bounds__(NT, 2) mega(Params p_) {
    extern __shared__ __attribute__((aligned(16))) char lds[];
    volatile LAS unsigned* bst = (volatile LAS unsigned*)(lds + LDS_QSLOT + 16);
    if (threadIdx.x == 0) { bst[0] = 0u; bst[1] = 0u; }
    if ((threadIdx.x & 63) == 0) ((volatile LAS int*)(lds + LDS_WTAB))[(unsigned)__builtin_amdgcn_s_getreg((5 << 11) | 4) & 63u] = threadIdx.x >> 6;
    __syncthreads();
#if defined(__HIP_DEVICE_COMPILE__)
    { const Params p = *kparams(); (void)xcd_barrier_post((unsigned*)(p.ws + WS_CTL) + 4096, bst); }
#define GSYNC() do { const Params p = *kparams(); XcdBarrier xb_; xb_.bar = (unsigned*)(p.ws + WS_CTL) + 4096; xb_.x = xb_xcc_id(); xb_.st = (volatile LAS unsigned*)(lds + LDS_QSLOT + 16); xcd_barrier(xb_); } while (0)
#else
#define GSYNC() do { } while (0)
#endif
    PH(ph_prep(p, lds));
    if (p_.out == nullptr) cooperative_groups::this_grid().sync();
    GSYNC();
#define LAYER(l) do { PH(ph_norm(p, l)); GSYNC(); PH(ph_gemm_in(p, l, lds)); if ((l) == 0) PH(ph_filler(p, lds, 0)); GSYNC(); PH(ph_mix(p, l, lds)); GSYNC(); PH(ph_gemm_out(p, l, lds)); GSYNC(); } while (0)
    LAYER(0);
    LAYER(1);
    PH(ph_final(p));
}

extern "C" void kernel_launch(void* const* d_in, const int* in_sizes, int n_in, void* d_out, int out_size, void* d_ws, size_t ws_size, hipStream_t stream) {
    static int grid_blocks = 0;
    if (grid_blocks == 0) {
        if (n_in != 33 || ws_size < WS_END) { fprintf(stderr, "kernel_launch: n_in %d ws %zu need %zu\n", n_in, ws_size, (size_t)WS_END); grid_blocks = -1; return; }
        if (hipFuncSetAttribute((const void*)mega, hipFuncAttributeMaxDynamicSharedMemorySize, LDS_TOTAL) != hipSuccess) { fprintf(stderr, "hipFuncSetAttribute failed\n"); grid_blocks = -1; return; }
        int dev = 0, cus = 0, per_cu = 0;
        (void)hipGetDevice(&dev); (void)hipDeviceGetAttribute(&cus, hipDeviceAttributeMultiprocessorCount, dev);
        (void)hipOccupancyMaxActiveBlocksPerMultiprocessor(&per_cu, (const void*)mega, NT, LDS_TOTAL);
        if (per_cu < 1) { fprintf(stderr, "occupancy query says %d blocks per CU\n", per_cu); grid_blocks = -1; return; }
        grid_blocks = cus;
    }
    if (grid_blocks < 0) return;
    Params p{};
    const float** pp = (const float**)&p;
    for (int i = 0; i < 33; ++i) pp[i] = (const float*)d_in[i];
    p.out = (float*)d_out; p.ws = (unsigned char*)d_ws;
    (void)hipMemsetAsync((char*)d_ws + WS_CTL, 0, 65536 + MOD_BYTES, stream);
    void* args[] = {&p};
    const hipError_t e = hipLaunchCooperativeKernel((const void*)mega, dim3(grid_blocks), dim3(NT), args, LDS_TOTAL, stream);
    if (e != hipSuccess) fprintf(stderr, "launch failed: %s (grid %d)\n", hipGetErrorString(e), grid_blocks);
}
```

```cpp
#include <hip/hip_runtime.h>
#include <hip/hip_cooperative_groups.h>
#include <cstdint>
#include <cstdio>
#include <type_traits>

#define DEVI __device__ __forceinline__
typedef unsigned short bf16_t;
using bf16x8 = __attribute__((ext_vector_type(8))) short;
using f32x4 = __attribute__((ext_vector_type(4))) float;

constexpr int D = 2048, NB = 32, SEQ = 256, DEPTH = 2, DB = 2, DSEQ = 1024, PAST = 512;
constexpr int NH = 8, IN_W = 7168;
constexpr int MC = NB * SEQ, MS = DB * DSEQ, MT = MC + MS;
constexpr int CQ = 0, CK = 1024, CV = 2048, CAG = 3072, CLX = 4096, CLG = 4608, CHV = 5120, CHX1 = 5632, CHX0 = 6144, CHG = 6656;
constexpr int NT = 512;

constexpr size_t OUT_YP = 0, OUT_YS = (size_t)MC * D, OUT_K = (size_t)MT * D, OUT_V = OUT_K + (size_t)NB * DEPTH * SEQ * 1024,
                 OUT_ST = OUT_V + (size_t)NB * DEPTH * SEQ * 1024;

constexpr size_t WS_CTL = 0;
constexpr size_t WS_MOD = 65536;
constexpr size_t MOD_BYTES = (size_t)2 * 3 * 6144 * 4;
constexpr size_t WS_ROPE = WS_MOD + MOD_BYTES;
constexpr size_t WS_FILT = WS_ROPE + 2 * 1024 * 32 * 4;
constexpr size_t FILT_PER_LAYER = (size_t)2 * 256 * 512 + (size_t)2 * 1024 * 512;
constexpr size_t WS_CKB = WS_FILT + 2 * FILT_PER_LAYER * 4;
constexpr size_t CACHE_ELEMS = (size_t)DB * DEPTH * PAST * 1024;
constexpr size_t WS_CVB = WS_CKB + CACHE_ELEMS * 2;
constexpr size_t WS_WGB = WS_CVB + CACHE_ELEMS * 2;
constexpr size_t WS_WINT = WS_WGB + (size_t)2 * 8 * 2 * 2 * 64 * 64 * 2;
constexpr size_t WS_WOUTT = WS_WINT + (size_t)2 * IN_W * D * 2;
constexpr size_t WS_H = WS_WOUTT + (size_t)2 * D * D * 2;
constexpr size_t WS_P = WS_H + (size_t)MT * D * 2;
constexpr size_t WS_MIX = WS_P + (size_t)MT * IN_W * 2;
constexpr size_t SCR1 = (size_t)MT * 512 * 4;
constexpr size_t WS_HS = WS_MIX + (size_t)MT * D * 2;
constexpr size_t WS_SA = WS_HS + SCR1, WS_SB = WS_SA + SCR1;
constexpr size_t WS_GS = WS_SB + SCR1;
constexpr size_t GS_L256 = (size_t)512 * 512, GS_PER_LAYER = GS_L256 + (size_t)512 * 2048;
constexpr size_t WS_PH = WS_GS + 2 * GS_PER_LAYER * 2;
constexpr size_t WS_END = WS_PH + (size_t)MT * 2048 * 2;

struct Params {
    const float *x_prompt, *x_sample, *cache_k, *cache_v, *state_lru, *c, *c_ctx, *norm_g, *w_ada, *b_ada, *w_in, *w_out,
        *lam_q1, *lam_k1, *lam_q2, *lam_k2, *subln_g, *lru_conv_w, *lru_conv_b, *lru_wa, *lru_ba, *lru_wi, *lru_bi, *lru_lam,
        *hy_conv_w, *hy_conv_b, *hy_w1, *hy_b1, *hy_w2, *hy_b2, *hy_w3, *hy_d, *final_g;
    float* out; unsigned char* ws;
};

#define LAS __attribute__((address_space(3)))
constexpr int LDS_QSLOT = 131072, LDS_WTAB = LDS_QSLOT + 64, LDS_TOTAL = LDS_QSLOT + 64 + 256;
DEVI char* dyn_lds() { extern __shared__ __attribute__((aligned(16))) char lds_dyn_[]; return lds_dyn_; }
DEVI int opaque_tid() {
    const unsigned hw = (unsigned)__builtin_amdgcn_s_getreg((5 << 11) | 4) & 63u;
    int wv = ((volatile LAS int*)(dyn_lds() + LDS_WTAB))[hw];
    wv = __builtin_amdgcn_readfirstlane(wv);
    int lane; asm volatile("v_mbcnt_lo_u32_b32 %0, -1, 0\n\tv_mbcnt_hi_u32_b32 %0, -1, %0" : "=v"(lane));
    return wv * 64 + lane;
}
#define TIDX opaque_tid()
typedef const __attribute__((address_space(4))) Params* KP;
DEVI KP kparams() { KP k = (KP)__builtin_amdgcn_kernarg_segment_ptr(); asm volatile("" : "+s"(k)); return k; }
#if defined(__HIP_DEVICE_COMPILE__)
#define KPARAMS(name) const Params name = *kparams()
#else
#define KPARAMS(name) const Params name{}
#endif
DEVI bf16_t f2bf(float f) { unsigned u = __float_as_uint(f); u += 0x7fffu + ((u >> 16) & 1u); return (bf16_t)(u >> 16); }
typedef unsigned u32x4 __attribute__((ext_vector_type(4)));
typedef __bf16 bf16x2_t __attribute__((ext_vector_type(2)));
typedef float f32x2_t __attribute__((ext_vector_type(2)));
DEVI unsigned pk2bf(float lo, float hi) { const f32x2_t v = {lo, hi}; return __builtin_bit_cast(unsigned, __builtin_convertvector(v, bf16x2_t)); }
DEVI float bf2f(bf16_t h) { return __uint_as_float(((unsigned)h) << 16); }
DEVI float silu_f(float x) { return x / (1.f + expf(-x)); }
DEVI float sigmoid_f(float x) { return 1.f / (1.f + expf(-x)); }
DEVI float lru_fsig(float x) { return __builtin_amdgcn_rcpf(1.0f + __builtin_amdgcn_exp2f(-1.4426950408889634f * x)); }
template <int K> DEVI float swz_xor(float v) { return __int_as_float(__builtin_amdgcn_ds_swizzle(__float_as_int(v), 0x1f | (K << 10))); }
DEVI float half_sum(float v) { v += swz_xor<1>(v); v += swz_xor<2>(v); v += swz_xor<4>(v); v += swz_xor<8>(v); v += swz_xor<16>(v); return v; }
DEVI float wave_sum(float v) { v = half_sum(v); auto rr = __builtin_amdgcn_permlane32_swap(__float_as_uint(v), __float_as_uint(v), false, false); return __uint_as_float(rr[0]) + __uint_as_float(rr[1]); }
DEVI int cond_of_row(int row) { return row < MC ? 0 : 1 + (row - MC) / DSEQ; }
DEVI float lam_init_of(int l) { return l == 0 ? 0.2f : (0.8f - 0.6f * 0.74081822068171786607f); }

struct TrItem { const float* W; bf16_t* WT; int N, k0, n0; };
DEVI TrItem tr_decode(const Params& p, int r) {
    TrItem it;
    if (r < 3584) { const int l = r / 1792, q = r % 1792; it.W = p.w_in + (size_t)l * D * IN_W; it.WT = (bf16_t*)(p.ws + WS_WINT) + (size_t)l * IN_W * D; it.N = IN_W; it.k0 = (q / 56) * 64; it.n0 = (q % 56) * 128; }
    else { const int r2 = r - 3584, l = r2 / 512, q = r2 % 512; it.W = p.w_out + (size_t)l * D * D; it.WT = (bf16_t*)(p.ws + WS_WOUTT) + (size_t)l * D * D; it.N = D; it.k0 = (q / 16) * 64; it.n0 = (q % 16) * 128; }
    return it;
}
DEVI void tr_load(const TrItem& it, int t, f32x4 (&r)[4]) {
#pragma unroll
    for (int i = 0; i < 4; ++i) { const int idx = i * 512 + t, row = idx >> 5, c4 = idx & 31; r[i] = *(const f32x4*)(it.W + (size_t)(it.k0 + row) * it.N + it.n0 + c4 * 4); }
}
DEVI void tr_store(const TrItem& it, int t, const f32x4 (&r)[4], float* tile  ) {
#pragma unroll
    for (int i = 0; i < 4; ++i) { const int idx = i * 512 + t, row = idx >> 5, c4 = idx & 31;
#pragma unroll
        for (int e = 0; e < 4; ++e) tile[row * 129 + c4 * 4 + e] = r[i][e]; }
    __syncthreads();
#pragma unroll
    for (int j = 0; j < 2; ++j) { const int o = j * 512 + t, kg = o & 7, n = o >> 3; float v[8];
#pragma unroll
        for (int e = 0; e < 8; ++e) v[e] = tile[(kg * 8 + e) * 129 + n];
        u32x4 w; w.x = pk2bf(v[0], v[1]); w.y = pk2bf(v[2], v[3]); w.z = pk2bf(v[4], v[5]); w.w = pk2bf(v[6], v[7]);
        *(u32x4*)(it.WT + (size_t)(it.n0 + n) * D + it.k0 + kg * 8) = w; }
    __syncthreads();
}
DEVI void mods_item(const Params& p, int item, float* sc  ) {
    const int l = item / 96, kc = (item / 3) % 32, nb = item % 3, t = TIDX;
    float* MOD = (float*)(p.ws + WS_MOD);
    if (t < 192) { const int j = t >> 6, kk = t & 63, k = kc * 64 + kk; const float cv = (j == 0) ? p.c_ctx[k] : p.c[(j - 1) * D + k]; sc[j * 64 + kk] = silu_f(cv); }
    __syncthreads();
    const int n = nb * 2048 + t * 4; f32x4 a0 = {0.f, 0.f, 0.f, 0.f}, a1 = a0, a2 = a0;
    const float* w = p.w_ada + ((size_t)l * D + kc * 64) * 6144 + n;
#pragma unroll 16
    for (int kk = 0; kk < 64; ++kk) { const f32x4 wv = *(const f32x4*)(w + (size_t)kk * 6144); a0 += sc[kk] * wv; a1 += sc[64 + kk] * wv; a2 += sc[128 + kk] * wv; }
    if (kc == 0) { const f32x4 bv = *(const f32x4*)(p.b_ada + l * 6144 + n); a0 += bv; a1 += bv; a2 += bv; }
#pragma unroll
    for (int e = 0; e < 4; ++e) { atomicAdd(&MOD[(l * 3 + 0) * 6144 + n + e], a0[e]); atomicAdd(&MOD[(l * 3 + 1) * 6144 + n + e], a1[e]); atomicAdd(&MOD[(l * 3 + 2) * 6144 + n + e], a2[e]); }
    __syncthreads();
}
DEVI void filter_item(const Params& p, int item, float* sm  ) {
    const int l = item / 80, r = item % 80, Lsel = r >= 16, pos0 = (Lsel ? r - 16 : r) * 16, L = Lsel ? 1024 : 256, t = TIDX;
    float* z = sm; float* h1 = sm + 16 * 36; float* h2 = h1 + 16 * 64;
    {
        const int pp = t >> 5, q = t & 31;
        const int pos = pos0 + pp; const float tt = (float)pos / (float)(L - 1);
        const int i = q & 15; const float band = 1e-4f + (float)i * ((15.0f - 1e-4f) / 15.0f); const float ang = (6.283185307179586f / (float)L) * (float)pos * band;
        z[pp * 36 + 1 + q] = (q < 16) ? cosf(ang) : sinf(ang);
        if (q == 0) z[pp * 36] = tt;
    }
    __syncthreads();
#pragma unroll
    for (int e = 0; e < 2; ++e) { const int idx = e * 512 + t, pp = idx >> 6, j = idx & 63; float a = p.hy_b1[l * 64 + j]; float w[33];
        _Pragma("unroll") for (int i = 0; i < 33; ++i) w[i] = p.hy_w1[(l * 33 + i) * 64 + j];
        _Pragma("unroll") for (int i = 0; i < 33; ++i) a += z[pp * 36 + i] * w[i]; h1[pp * 64 + j] = sinf(a); }
    __syncthreads();
#pragma unroll
    for (int e = 0; e < 2; ++e) { const int idx = e * 512 + t, pp = idx >> 6, j = idx & 63; float a = p.hy_b2[l * 64 + j];
        _Pragma("unroll 1") for (int i0 = 0; i0 < 64; i0 += 32) { float w[32];
            _Pragma("unroll") for (int i = 0; i < 32; ++i) w[i] = p.hy_w2[(l * 64 + i0 + i) * 64 + j];
            _Pragma("unroll") for (int i = 0; i < 32; ++i) a += h1[pp * 64 + i0 + i] * w[i]; }
        h2[pp * 64 + j] = sinf(a); }
    __syncthreads();
    float* F = (float*)(p.ws + WS_FILT) + (size_t)l * FILT_PER_LAYER + (Lsel ? (size_t)2 * 256 * 512 : 0);
    const float lo = 3.0701134573253945f, hi = 15.350567286626973f, delta = lo + (float)t * ((hi - lo) / 511.0f);
#pragma unroll
    for (int q = 0; q < 2; ++q) {
        const int n = q * 512 + t; float a[16];
#pragma unroll
        for (int pp = 0; pp < 16; ++pp) a[pp] = 0.f;
#pragma unroll 1
        for (int k0 = 0; k0 < 64; k0 += 16) { float w[16];
#pragma unroll
            for (int k = 0; k < 16; ++k) w[k] = p.hy_w3[(size_t)(l * 64 + k0 + k) * 1024 + n];
#pragma unroll
            for (int k = 0; k < 16; ++k)
#pragma unroll
                for (int pp = 0; pp < 16; ++pp) a[pp] += h2[pp * 64 + k0 + k] * w[k]; }
        float* dst = F + ((size_t)q * 512 + t) * L + pos0;
#pragma unroll
        for (int g = 0; g < 4; ++g) { f32x4 o;
#pragma unroll
            for (int e = 0; e < 4; ++e) { const int pp = g * 4 + e; o[e] = a[pp] * expf(-((float)(pos0 + pp) / (float)(L - 1)) * delta); }
            *(f32x4*)(dst + g * 4) = o; }
    }
    __syncthreads();
}
DEVI void gs_item(const Params& p, int it) {
    const int t = TIDX;
    {
        const int l = it >> 7, Lsel = (it >> 6) & 1, c8 = (it & 63) * 8, L = Lsel ? 1024 : 256;
        const float* F0 = (const float*)(p.ws + WS_FILT) + (size_t)l * FILT_PER_LAYER + (Lsel ? (size_t)2 * 256 * 512 : 0);
        bf16_t* G0 = (bf16_t*)(p.ws + WS_GS) + (size_t)l * GS_PER_LAYER + (Lsel ? GS_L256 : 0);
        const int nchunk = 8 * 2 * L / 8;
        for (int cidx = t; cidx < nchunk; cidx += NT) {
            const int c = cidx / (2 * L / 8), i0 = (cidx % (2 * L / 8)) * 8, ch = c8 + c;
            const float* Ff = F0 + (size_t)ch * L; const float* Fb = Ff + (size_t)512 * L; const float dsk = p.hy_d[l * 512 + ch];
            float v[8];
#pragma unroll
            for (int e = 0; e < 8; ++e) { const int d = L - 1 - (i0 + e); float g = 0.f;
                if (d > 0 && d < L) g = Ff[d]; else if (d < 0 && -d < L) g = Fb[-d]; else if (d == 0) g = Ff[0] + dsk;
                v[e] = g; }
            u32x4 w; w.x = pk2bf(v[0], v[1]); w.y = pk2bf(v[2], v[3]); w.z = pk2bf(v[4], v[5]); w.w = pk2bf(v[6], v[7]);
            *(u32x4*)(G0 + (size_t)ch * 2 * L + i0) = w;
        }
    }
}
DEVI void small_item(const Params& p, int kind, int r, int t) {
    if (kind == 0) {
        const int e = r * 512 + t, c = e & 63, d = (e >> 6) & 63, gate = (e >> 12) & 1, dir = (e >> 13) & 1, n = (e >> 14) & 7, l = e >> 17;
        const float* src = gate ? p.lru_wi : p.lru_wa;
        ((bf16_t*)(p.ws + WS_WGB))[e] = f2bf(src[((size_t)((l * 2 + dir) * 8 + n) * 64 + c) * 64 + d]);
    } else if (kind == 1) {
        const size_t e = ((size_t)r * 512 + t) * 8; const bool isv = e >= CACHE_ELEMS; const size_t o = isv ? e - CACHE_ELEMS : e;
        const float* src = (isv ? p.cache_v : p.cache_k) + o; const f32x4 x0 = *(const f32x4*)src, x1 = *(const f32x4*)(src + 4);
        u32x4 w; w.x = pk2bf(x0[0], x0[1]); w.y = pk2bf(x0[2], x0[3]); w.z = pk2bf(x1[0], x1[1]); w.w = pk2bf(x1[2], x1[3]);
        *(u32x4*)((bf16_t*)(p.ws + (isv ? WS_CVB : WS_CKB)) + o) = w;
    } else {
        const int e = r * 512 + t, tpos = e >> 5, axis = (e >> 4) & 1, f = e & 15;
        const float inv = powf(10000.0f, -(float)f / 16.0f), pv = (float)(axis == 0 ? (tpos >> 6) : (tpos & 63)), ang = pv * inv;
        float* RC = (float*)(p.ws + WS_ROPE);
        RC[e] = cosf(ang); RC[1024 * 32 + e] = sinf(ang);
    }
}
constexpr int I_MOD = 192, I_FILT = 2 * 80, I_ROPE = 64, I_CACHE = (int)(2 * CACHE_ELEMS / (512 * 8)), I_WG = 2 * 8 * 2 * 2 * 64 * 64 / 512, I_TR0 = 1792, I_TR = 3584 + 1024, I_GS = 256;
DEVI void ph_prep(const Params& p, char* lds) {
    float* sm = (float*)lds;
    const int t = TIDX;
    for (int it = blockIdx.x; it < 96 + 80 + I_ROPE; it += gridDim.x) {
        int r = it;
        if (r < 96) { mods_item(p, r, sm); continue; } r -= 96;
        if (r < 80) { filter_item(p, r, sm); continue; } r -= 80;
        small_item(p, 2, r, t);
    }
    __syncthreads();
    {
        int it = blockIdx.x; f32x4 cur[4], nxt[4]; TrItem ci, ni;
        if (it < I_TR0) { ci = tr_decode(p, it); tr_load(ci, t, cur); }
        while (it < I_TR0) {
            const int itn = it + gridDim.x; const bool more = itn < I_TR0;
            if (more) { ni = tr_decode(p, itn); tr_load(ni, t, nxt); }
            tr_store(ci, t, cur, sm);
            if (more) { ci = ni;
#pragma unroll
                for (int i = 0; i < 4; ++i) cur[i] = nxt[i]; }
            it = itn;
        }
    }
}
DEVI void tr_batch(const Params& p, int first, int count, int t, float* sm) {
    f32x4 cur[4], nxt[4]; TrItem ci = tr_decode(p, first), ni = ci;
    tr_load(ci, t, cur);
#pragma unroll 1
    for (int k = 0; k < count; ++k) {
        const bool more = k + 1 < count;
        if (more) { ni = tr_decode(p, first + k + 1); tr_load(ni, t, nxt); }
        tr_store(ci, t, cur, sm);
        if (more) { ci = ni;
#pragma unroll
            for (int i = 0; i < 4; ++i) cur[i] = nxt[i]; }
    }
}
DEVI void ph_filler(const Params& p, char* lds, int stage) {
    float* sm = (float*)lds;
    const int t = TIDX;
    const int NF = stage == 0 ? 96 + 80 + 128 + 128 + I_CACHE / 8 + I_WG / 8 : (stage == 1 ? 448 : 256);
    unsigned* qctr = (unsigned*)(p.ws + WS_CTL) + 2048 + 64 * stage;
    volatile int* slot = (volatile int*)(lds + LDS_QSLOT);
    for (;;) {
        __syncthreads();
        if (t == 0) *slot = (int)__hip_atomic_fetch_add(qctr, 1u, __ATOMIC_RELAXED, __HIP_MEMORY_SCOPE_AGENT);
        __syncthreads();
        int r = __builtin_amdgcn_readfirstlane(*slot);
        if (r >= NF) break;
        if (stage == 0) {
            if (r < 96) { mods_item(p, 96 + r, sm); continue; } r -= 96;
            if (r < 80) { filter_item(p, 80 + r, sm); continue; } r -= 80;
            if (r < 128) { gs_item(p, r); continue; } r -= 128;
            if (r < 128) { tr_batch(p, 3584 + 4 * r, 4, t, sm); continue; } r -= 128;
            if (r < I_CACHE / 8) { for (int k = 0; k < 8; ++k) small_item(p, 1, r * 8 + k, t); continue; } r -= I_CACHE / 8;
            for (int k = 0; k < 8; ++k) small_item(p, 0, r * 8 + k, t);
        } else if (stage == 1) {
            tr_batch(p, 1792 + 4 * r, 4, t, sm);
        } else {
            if (r < 128) { gs_item(p, 128 + r); continue; } r -= 128;
            tr_batch(p, 3584 + 512 + 4 * r, 4, t, sm);
        }
    }
}

DEVI void ph_norm(const Params& p, int l) {
    const int wid = TIDX >> 6, lane = TIDX & 63, gw = blockIdx.x * (NT / 64) + wid, NGW = gridDim.x * (NT / 64);
    const float* X = p.out;
    const float* MOD = (const float*)(p.ws + WS_MOD);
    bf16_t* H = (bf16_t*)(p.ws + WS_H);
    for (int row = gw; row < MT; row += NGW) {
        const float* xr = (l == 0) ? (row < MC ? p.x_prompt + (size_t)row * D : p.x_sample + (size_t)(row - MC) * D) : X + (size_t)row * D;
        const float* md = MOD + (size_t)(l * 3 + cond_of_row(row)) * 6144;
        f32x4 v[8]; float ss = 0.f;
#pragma unroll
        for (int j = 0; j < 8; ++j) { v[j] = *(const f32x4*)(xr + j * 256 + lane * 4); ss += v[j][0] * v[j][0] + v[j][1] * v[j][1] + v[j][2] * v[j][2] + v[j][3] * v[j][3]; }
        const float rs = rsqrtf(wave_sum(ss) * (1.0f / D) + 1e-6f);
#pragma unroll
        for (int hf = 0; hf < 2; ++hf) {
            f32x4 g[4], sh[4], scl[4];
#pragma unroll
            for (int jj = 0; jj < 4; ++jj) { const int c0 = (hf * 4 + jj) * 256 + lane * 4; g[jj] = *(const f32x4*)(p.norm_g + l * D + c0); sh[jj] = *(const f32x4*)(md + c0); scl[jj] = *(const f32x4*)(md + 2048 + c0); }
#pragma unroll
            for (int jj = 0; jj < 4; ++jj) {
                const int j = hf * 4 + jj, c0 = j * 256 + lane * 4;
                float o[4];
#pragma unroll
                for (int e = 0; e < 4; ++e) o[e] = v[j][e] * rs * g[jj][e] * (1.0f + scl[jj][e]) + sh[jj][e];
                *(uint2*)(H + (size_t)row * D + c0) = make_uint2(pk2bf(o[0], o[1]), pk2bf(o[2], o[3]));
            }
        }
    }
}

constexpr int BM = 256, BK = 64, HALF = 128, HTB = HALF * BK * 2, GEMM_LDS = 8 * HTB;
DEVI int lds_byte(int r, int c) { const int st = (r >> 4) * 2 + (c >> 5), rr = r & 15, cc = c & 31, ob = rr * 64 + cc * 2; return st * 1024 + (ob ^ (((ob >> 9) & 1) << 5)); }
DEVI void stage_rc(int b, int& R, int& C) { const int st = b / 1024, sb = b % 1024, swz = sb ^ (((sb >> 9) & 1) << 5); R = (st >> 1) * 16 + swz / 64; C = (st & 1) * 32 + (swz % 64) / 2; }
DEVI int perm32(int rho) { const int n = rho >> 4, i = rho & 15; return 8 * (i >> 2) + 4 * n + (i & 3); }
struct Unit { int pm, pn; };
struct StaticOrder {
    int nM, nN, nwg, G, c;
    DEVI void init(int M, int N, int G_, int c_) { nM = M / BM; nN = N / BM; nwg = nM * nN; G = G_; c = c_; }
    DEVI bool next(int i, Unit& u) const {
        const long L = (long)i * G + c; if (L >= nwg) return false;
        int wgid = (int)L; { const int q = nwg / 8, r = nwg % 8, xcd = wgid % 8, off = wgid / 8; wgid = (xcd < r ? xcd * (q + 1) : r * (q + 1) + (xcd - r) * q) + off; }
        const int nig = 8 * nN, gid = wgid / nig, fm = gid * 8, gsz = (nM - fm) < 8 ? (nM - fm) : 8;
        u.pm = fm + ((wgid % nig) % gsz); u.pn = (wgid % nig) / gsz; return true;
    }
};
template <class Epi>
DEVI void gemm_phase(LAS unsigned char* lds, const bf16_t* gA, const bf16_t* gBt, const int K, const StaticOrder& S, const Epi& E) {
    const int tid = TIDX, wid = __builtin_amdgcn_readfirstlane(tid >> 6), lane = tid & 63, wr = wid >> 2, wc = wid & 3, fr = lane & 15, fq = lane >> 4;
    const int nt = K / BK;
    unsigned voffA[2], voffB[2];
#pragma unroll
    for (int i = 0; i < 2; ++i) { int R, C; stage_rc(tid * 16 + i * 8192, R, C); const int Rb = Epi::PERM ? ((R & ~31) + perm32(R & 31)) : R;
        voffA[i] = (unsigned)(R * K + C) * 2u; voffB[i] = (unsigned)(Rb * K + C) * 2u; }
    const size_t kstep = (size_t)(BK * 2), hstep = (size_t)HALF * K * 2, tstep = 2 * hstep;
    const unsigned ldsw = (unsigned)wid * 1024u;
    const int aoff = lds_byte(wr * 64 + fr, fq * 8), boff = lds_byte(wc * 32 + fr, fq * 8);
#define PG8_SA(b, h) (((b) * 2 + (h)) * HTB)
#define PG8_SB(b, h) ((4 + (b) * 2 + (h)) * HTB)
#define PG8_STAGE(bufoff, gbase, voff) do { _Pragma("unroll") for (int _i = 0; _i < 2; ++_i) \
        __builtin_amdgcn_global_load_lds((const unsigned*)((const char*)(gbase) + (voff)[_i]), (LAS unsigned*)(lds + (bufoff) + ldsw + _i * 8192), 16, 0, 0); } while (0)
#define PG8_LDA(dst, b, h) do { _Pragma("unroll") for (int m = 0; m < 4; ++m) _Pragma("unroll") for (int k = 0; k < 2; ++k) dst[m][k] = *(const LAS bf16x8*)(lds + PG8_SA(b, h) + aoff + m * 2048 + k * 1024); } while (0)
#define PG8_LDB(dst, b, h) do { _Pragma("unroll") for (int n = 0; n < 2; ++n) _Pragma("unroll") for (int k = 0; k < 2; ++k) dst[n][k] = *(const LAS bf16x8*)(lds + PG8_SB(b, h) + boff + n * 2048 + k * 1024); } while (0)
#define PG8_MMA(ai, bj, At, Bt) do { __builtin_amdgcn_s_setprio(1); _Pragma("unroll") for (int m = 0; m < 4; ++m) _Pragma("unroll") for (int n = 0; n < 2; ++n) _Pragma("unroll") for (int k = 0; k < 2; ++k) \
        acc[ai][bj][m][n] = __builtin_amdgcn_mfma_f32_16x16x32_bf16(Bt[n][k], At[m][k], acc[ai][bj][m][n], 0, 0, 0); __builtin_amdgcn_s_setprio(0); } while (0)
#define PG8_WAIT_V(n) asm volatile("s_waitcnt vmcnt(" #n ")" ::: "memory")
#define PG8_WAIT_L(n) asm volatile("s_waitcnt lgkmcnt(" #n ")" ::: "memory")
#define PG8_BAR __builtin_amdgcn_s_barrier()
#define PG8_SCHED __builtin_amdgcn_sched_barrier(0)
    Unit cur, nxt; int ui = 0;
    if (!S.next(0, cur)) return;
    f32x4 acc[2][2][4][2];
#pragma unroll
    for (int a = 0; a < 2; ++a)
#pragma unroll
        for (int b = 0; b < 2; ++b)
#pragma unroll
            for (int m = 0; m < 4; ++m)
#pragma unroll
                for (int n = 0; n < 2; ++n) acc[a][b][m][n] = (f32x4){0.f, 0.f, 0.f, 0.f};
    bf16x8 At[4][2], B0[2][2], B1[2][2];
    const char* cA = (const char*)gA + (size_t)cur.pm * tstep; const char* cB = (const char*)gBt + (size_t)cur.pn * tstep;
    PG8_STAGE(PG8_SB(0, 0), cB, voffB); PG8_STAGE(PG8_SB(0, 1), cB + hstep, voffB); PG8_STAGE(PG8_SA(0, 0), cA, voffA); PG8_STAGE(PG8_SA(0, 1), cA + hstep, voffA);
    if (wr == 1) PG8_BAR;
    PG8_WAIT_V(2); PG8_BAR;
    PG8_STAGE(PG8_SB(1, 0), cB + kstep, voffB); PG8_STAGE(PG8_SA(1, 0), cA + kstep, voffA); PG8_STAGE(PG8_SB(1, 1), cB + hstep + kstep, voffB);
    PG8_WAIT_V(6); PG8_BAR;
    for (;;) {
        const bool has_next = S.next(ui + 1, nxt);
        const char* nA = has_next ? (const char*)gA + (size_t)nxt.pm * tstep : cA; const char* nB = has_next ? (const char*)gBt + (size_t)nxt.pn * tstep : cB;
        for (int t = 0; t < nt; t += 2) {
            const bool last = (t == nt - 2);
            const char* a1 = cA + (size_t)(t + 1) * kstep;
            const char* a2 = last ? nA : cA + (size_t)(t + 2) * kstep; const char* b2 = last ? nB : cB + (size_t)(t + 2) * kstep;
            const char* a3 = a2 + kstep; const char* b3 = b2 + kstep;
            PG8_LDB(B0, 0, 0); PG8_LDB(B1, 0, 1); PG8_SCHED; PG8_LDA(At, 0, 0); PG8_STAGE(PG8_SA(1, 1), a1 + hstep, voffA);
            PG8_WAIT_V(8); PG8_WAIT_L(0); PG8_BAR; PG8_MMA(0, 0, At, B0); PG8_MMA(0, 1, At, B1); PG8_BAR; PG8_SCHED;
            PG8_LDA(At, 0, 1); PG8_STAGE(PG8_SB(0, 0), b2, voffB); PG8_STAGE(PG8_SB(0, 1), b2 + hstep, voffB); PG8_STAGE(PG8_SA(0, 0), a2, voffA);
            PG8_WAIT_V(8); PG8_WAIT_L(0); PG8_BAR; PG8_MMA(1, 0, At, B0); PG8_MMA(1, 1, At, B1); PG8_BAR; PG8_SCHED;
            PG8_LDB(B0, 1, 0); PG8_LDB(B1, 1, 1); PG8_SCHED; PG8_LDA(At, 1, 0); PG8_STAGE(PG8_SA(0, 1), a2 + hstep, voffA);
            PG8_WAIT_V(8); PG8_WAIT_L(0); PG8_BAR; PG8_MMA(0, 0, At, B0); PG8_MMA(0, 1, At, B1); PG8_BAR; PG8_SCHED;
            PG8_LDA(At, 1, 1); PG8_STAGE(PG8_SB(1, 0), b3, voffB); PG8_STAGE(PG8_SB(1, 1), b3 + hstep, voffB); PG8_STAGE(PG8_SA(1, 0), a3, voffA);
            PG8_WAIT_V(8); PG8_WAIT_L(0); PG8_BAR; PG8_MMA(1, 0, At, B0); PG8_MMA(1, 1, At, B1); PG8_BAR; PG8_SCHED;
        }
        if (wr == 0) PG8_BAR;
        E(acc, cur, wr, wc, fr, fq);
        if (!has_next) break;
#pragma unroll
        for (int a = 0; a < 2; ++a)
#pragma unroll
            for (int b = 0; b < 2; ++b)
#pragma unroll
                for (int m = 0; m < 4; ++m)
#pragma unroll
                    for (int n = 0; n < 2; ++n) acc[a][b][m][n] = (f32x4){0.f, 0.f, 0.f, 0.f};
        cur = nxt; cA = nA; cB = nB; ++ui;
        if (wr == 1) PG8_BAR;
    }
    PG8_WAIT_V(0);
    PG8_BAR;
}
template <class Epi>
DEVI void gemm_quarter(LAS unsigned char* lds, const bf16_t* gA, const bf16_t* gBt, const int K, const Epi& E) {
    const int tid = TIDX, wid = __builtin_amdgcn_readfirstlane(tid >> 6), lane = tid & 63, wr = wid >> 2, wc = wid & 3, fr = lane & 15, fq = lane >> 4;
    const int nt = K / BK;
    unsigned voff[2];
#pragma unroll
    for (int i = 0; i < 2; ++i) { int R, C; stage_rc(tid * 16 + i * 8192, R, C); voff[i] = (unsigned)(R * K + C) * 2u; }
    const size_t kstep = (size_t)(BK * 2);
    const unsigned ldsw = (unsigned)wid * 1024u;
    const int aoff = lds_byte(wr * 64 + fr, fq * 8), boff = lds_byte(wc * 32 + fr, fq * 8);
    f32x4 acc[1][1][4][2];
#pragma unroll
    for (int m = 0; m < 4; ++m)
#pragma unroll
        for (int n = 0; n < 2; ++n) acc[0][0][m][n] = (f32x4){0.f, 0.f, 0.f, 0.f};
    bf16x8 At[4][2], B0[2][2];
    const char* cA = (const char*)gA; const char* cB = (const char*)gBt;
#define QSTEP(r, tt) do { const int tn_ = ((tt) + 3 < nt) ? (tt) + 3 : nt - 1;     \
        PG8_WAIT_V(8); PG8_BAR; \
        PG8_STAGE(PG8_SB((((r) + 3) & 3) >> 1, ((r) + 3) & 1), cB + (size_t)tn_ * kstep, voff); PG8_STAGE(PG8_SA((((r) + 3) & 3) >> 1, ((r) + 3) & 1), cA + (size_t)tn_ * kstep, voff); \
        PG8_LDB(B0, (r) >> 1, (r) & 1); PG8_LDA(At, (r) >> 1, (r) & 1); PG8_WAIT_L(0); PG8_MMA(0, 0, At, B0); } while (0)
    PG8_STAGE(PG8_SB(0, 0), cB, voff); PG8_STAGE(PG8_SA(0, 0), cA, voff);
    PG8_STAGE(PG8_SB(0, 1), cB + kstep, voff); PG8_STAGE(PG8_SA(0, 1), cA + kstep, voff);
    PG8_STAGE(PG8_SB(1, 0), cB + 2 * kstep, voff); PG8_STAGE(PG8_SA(1, 0), cA + 2 * kstep, voff);
    for (int t = 0; t < nt; t += 4) { QSTEP(0, t); QSTEP(1, t + 1); QSTEP(2, t + 2); QSTEP(3, t + 3); }
#undef QSTEP
    E(acc[0][0], wr, wc, fr, fq);
    PG8_WAIT_V(0);
    PG8_BAR;
}
#undef PG8_SA
#undef PG8_SB
#undef PG8_STAGE
#undef PG8_LDA
#undef PG8_LDB
#undef PG8_MMA
struct EpiIn {
    static constexpr bool PERM = true;
    int l;
    DEVI void operator()(const f32x4 (&acc)[2][2][4][2], const Unit& u, int wr, int wc, int fr, int fq) const {
        KPARAMS(pe); bf16_t* P = (bf16_t*)(pe.ws + WS_P); float* out = pe.out; const float* RC = (const float*)(pe.ws + WS_ROPE);
        const int row0 = u.pm * BM + wr * 64 + fr, col0 = u.pn * BM + wc * 32 + 8 * fq;
        const bool cache = (row0 < MC) && (col0 >= CK) && (col0 < CAG);
        const bool hyt = col0 >= CHV; bf16_t* PHb = (bf16_t*)(pe.ws + WS_PH);
        const bool rope = (row0 >= MC) && (col0 < CV);
        const float* rcb = RC + (wc & 1) * 16 + 8 * (fq & 1); const float sgn = fq < 2 ? -1.f : 1.f;
#pragma unroll
        for (int ai = 0; ai < 2; ++ai)
#pragma unroll
            for (int m = 0; m < 4; ++m) {
                const int row = row0 + ai * HALF + m * 16;
                bf16_t* rowp = hyt ? PHb + ((size_t)((col0 - CHV) >> 3) * MT + row) * 8 : P + (size_t)row * IN_W + col0;
#pragma unroll
                for (int bj = 0; bj < 2; ++bj) {
                    f32x4 v0 = acc[ai][bj][m][0], v1 = acc[ai][bj][m][1];
                    if (rope) {
                        const float* rc = rcb + ((row - MC) & (DSEQ - 1)) * 32;
                        const f32x4 c0 = *(const f32x4*)rc, c1 = *(const f32x4*)(rc + 4), s0 = *(const f32x4*)(rc + 1024 * 32), s1 = *(const f32x4*)(rc + 1024 * 32 + 4);
#pragma unroll
                        for (int e = 0; e < 4; ++e) { const auto q0 = __builtin_amdgcn_permlane32_swap(__float_as_uint(v0[e]), __float_as_uint(v0[e]), false, false), q1 = __builtin_amdgcn_permlane32_swap(__float_as_uint(v1[e]), __float_as_uint(v1[e]), false, false);
                            const float p0 = __uint_as_float(fq < 2 ? q0[1] : q0[0]), p1 = __uint_as_float(fq < 2 ? q1[1] : q1[0]); v0[e] = v0[e] * c0[e] + sgn * p0 * s0[e]; v1[e] = v1[e] * c1[e] + sgn * p1 * s1[e]; }
                    }
                    u32x4 w; w.x = pk2bf(v0[0], v0[1]); w.y = pk2bf(v0[2], v0[3]); w.z = pk2bf(v1[0], v1[1]); w.w = pk2bf(v1[2], v1[3]);
                    *(u32x4*)(rowp + (hyt ? (size_t)(bj * HALF / 8) * MT * 8 : (size_t)(bj * HALF))) = w;
                    if (cache) {
                        const int col = col0 + bj * HALF, which = col >= CV, cc = col - CK - which * 1024, b = row >> 8, t = row & 255;
                        float* o = out + (which ? OUT_V : OUT_K) + ((size_t)(b * 2 + l) * 256 + t) * 1024 + cc;
                        *(f32x4*)o = v0; *(f32x4*)(o + 4) = v1;
                    }
                }
            }
    }
};
struct EpiOut {
    static constexpr bool PERM = false;
    int l;
    DEVI void operator()(const f32x4 (&acc)[2][2][4][2], const Unit& u, int wr, int wc, int fr, int fq) const {
        KPARAMS(pe); const float* xp = pe.x_prompt; const float* xs = pe.x_sample; float* X = pe.out; const float* MOD = (const float*)(pe.ws + WS_MOD);
        const int row0 = u.pm * BM + wr * 64 + fr, col0 = u.pn * BM + wc * 32 + 4 * fq;
        const float* gate = MOD + (size_t)(l * 3 + cond_of_row(u.pm * BM)) * 6144 + 4096 + col0;
        const float* xin = (l == 0) ? (row0 < MC ? xp : xs - (size_t)MC * D) : X;
#pragma unroll
        for (int bj = 0; bj < 2; ++bj)
#pragma unroll
            for (int n = 0; n < 2; ++n) {
                const f32x4 g = *(const f32x4*)(gate + bj * HALF + n * 16);
                f32x4 xv[2][4];
#pragma unroll
                for (int ai = 0; ai < 2; ++ai)
#pragma unroll
                    for (int m = 0; m < 4; ++m) xv[ai][m] = *(const f32x4*)(xin + (size_t)(row0 + ai * HALF + m * 16) * D + col0 + bj * HALF + n * 16);
#pragma unroll
                for (int ai = 0; ai < 2; ++ai)
#pragma unroll
                    for (int m = 0; m < 4; ++m) *(f32x4*)(X + (size_t)(row0 + ai * HALF + m * 16) * D + col0 + bj * HALF + n * 16) = xv[ai][m] + g * acc[ai][bj][m][n];
            }
    }
};
struct EpiOutQ {
    int l, rbase, cbase;
    DEVI void operator()(const f32x4 (&acc)[4][2], int wr, int wc, int fr, int fq) const {
        KPARAMS(pe); const float* xs = pe.x_sample; float* X = pe.out; const float* MOD = (const float*)(pe.ws + WS_MOD);
        const int row0 = rbase + wr * 64 + fr, col0 = cbase + wc * 32 + 4 * fq;
        const float* gate = MOD + (size_t)(l * 3 + cond_of_row(rbase)) * 6144 + 4096 + col0;
        const float* xin = (l == 0) ? xs - (size_t)MC * D : X;
#pragma unroll
        for (int n = 0; n < 2; ++n) {
            const f32x4 g = *(const f32x4*)(gate + n * 16);
            f32x4 xv[4];
#pragma unroll
            for (int m = 0; m < 4; ++m) xv[m] = *(const f32x4*)(xin + (size_t)(row0 + m * 16) * D + col0 + n * 16);
#pragma unroll
            for (int m = 0; m < 4; ++m) *(f32x4*)(X + (size_t)(row0 + m * 16) * D + col0 + n * 16) = xv[m] + g * acc[m][n];
        }
    }
};
DEVI void ph_gemm_in(const Params& p, int l, char* lds) {
    EpiIn e{l};
    StaticOrder S; S.init(MT, IN_W, gridDim.x, blockIdx.x);
    gemm_phase((LAS unsigned char*)lds, (const bf16_t*)(p.ws + WS_H), (const bf16_t*)(p.ws + WS_WINT) + (size_t)l * IN_W * D, D, S, e);
}
DEVI void ph_gemm_out(const Params& p, int l, char* lds) {
    EpiOut e{l};
    StaticOrder S; S.init(MC, D, gridDim.x, blockIdx.x);
    gemm_phase((LAS unsigned char*)lds, (const bf16_t*)(p.ws + WS_MIX), (const bf16_t*)(p.ws + WS_WOUTT) + (size_t)l * D * D, D, S, e);
    for (int q = blockIdx.x; q < (MS / HALF) * (D / HALF); q += gridDim.x) {
        const int x = q & 7, s = (q >> 3) & 31, qm = 4 * (x >> 1) + (s & 3), qn = 8 * (x & 1) + (s >> 2);
        EpiOutQ eq{l, MC + qm * HALF, qn * HALF};
        gemm_quarter((LAS unsigned char*)lds, (const bf16_t*)(p.ws + WS_MIX) + (size_t)(MC + qm * HALF) * D, (const bf16_t*)(p.ws + WS_WOUTT) + (size_t)l * D * D + (size_t)(qn * HALF) * D, D, eq);
    }
}

namespace att {
using s16x4 = __attribute__((ext_vector_type(4))) short;
using f32x16 = __attribute__((ext_vector_type(16))) float;
constexpr int KVBLK = 64, SHM_V = 64 * 128 * 2, SHM_K = 64 * 128 * 2;
constexpr float SCALE = 0.125f, THR = 8.f;
#define KSWZ(row, colB) ((row) * 256 + ((colB) ^ (((row) & 7) << 4)))
#define SBAR() __builtin_amdgcn_sched_barrier(0)
DEVI int crow(int r, int hi) { return (r & 3) + 8 * (r >> 2) + 4 * hi; }
DEVI unsigned cvtpk(float lo, float hi) { unsigned r; asm volatile("v_cvt_pk_bf16_f32 %0, %1, %2" : "=v"(r) : "v"(lo), "v"(hi)); return r; }
DEVI void partialSM(f32x16& p0, f32x16& p1, float& m_reg, float& mn, float& alpha) {
    constexpr float C = SCALE * 1.4426950408889634f;
    float pmax = p0[0];
#pragma unroll
    for (int r = 1; r < 16; ++r) pmax = fmaxf(pmax, p0[r]);
#pragma unroll
    for (int r = 0; r < 16; ++r) pmax = fmaxf(pmax, p1[r]);
    { auto rr = __builtin_amdgcn_permlane32_swap(__float_as_uint(pmax), __float_as_uint(pmax), false, false); pmax = fmaxf(__uint_as_float(rr[0]), __uint_as_float(rr[1])); }
    if (__builtin_expect(__all(pmax - m_reg <= THR / SCALE), 1)) { mn = m_reg; alpha = 1.f; }
    else { mn = fmaxf(m_reg, pmax); alpha = __builtin_amdgcn_exp2f((m_reg - mn) * C); m_reg = mn; }
    const float mnC = -mn * C;
#pragma unroll
    for (int r = 0; r < 16; ++r) p0[r] = fmaf(p0[r], C, mnC);
#pragma unroll
    for (int r = 0; r < 16; ++r) p1[r] = fmaf(p1[r], C, mnC);
#pragma unroll
    for (int r = 0; r < 16; ++r) p0[r] = __builtin_amdgcn_exp2f(p0[r]);
}
DEVI void finishSM(f32x16& p0, f32x16& p1, float alpha, float& l_reg, bf16x8& pa0, bf16x8& pa1, bf16x8& pa2, bf16x8& pa3) {
#pragma unroll
    for (int r = 0; r < 16; ++r) p1[r] = __builtin_amdgcn_exp2f(p1[r]);
    float ps = 0;
#pragma unroll
    for (int r = 0; r < 16; ++r) ps += p0[r];
#pragma unroll
    for (int r = 0; r < 16; ++r) ps += p1[r];
    { auto rr = __builtin_amdgcn_permlane32_swap(__float_as_uint(ps), __float_as_uint(ps), false, false); ps = __uint_as_float(rr[0]) + __uint_as_float(rr[1]); }
    l_reg = l_reg * alpha + ps;
#define PK4(P, BASE, OUT) do { unsigned a0 = cvtpk(P[BASE + 0], P[BASE + 1]), a1 = cvtpk(P[BASE + 2], P[BASE + 3]);   \
    unsigned b0 = cvtpk(P[BASE + 4], P[BASE + 5]), b1 = cvtpk(P[BASE + 6], P[BASE + 7]);                              \
    auto r0 = __builtin_amdgcn_permlane32_swap(a0, b0, false, false); auto r1 = __builtin_amdgcn_permlane32_swap(a1, b1, false, false); \
    u32x4 w = {r0[0], r1[0], r0[1], r1[1]}; OUT = *reinterpret_cast<bf16x8*>(&w); } while (0)
    PK4(p0, 0, pa0); PK4(p0, 8, pa1); PK4(p1, 0, pa2); PK4(p1, 8, pa3);
#undef PK4
}
DEVI void qkt(f32x16& p0, f32x16& p1, const char* Ks, const bf16x8* qr, int r32, int hi, int c) {
    p0 = f32x16{}; p1 = f32x16{};
#pragma unroll
    for (int d0 = 0; d0 < 4; ++d0) { const int cb = ((c * 4 + d0) * 16 + hi * 8) * 2;
        const bf16x8 b0 = *reinterpret_cast<const bf16x8*>(Ks + KSWZ(r32, cb));
        const bf16x8 b1 = *reinterpret_cast<const bf16x8*>(Ks + KSWZ(32 + r32, cb));
        p0 = __builtin_amdgcn_mfma_f32_32x32x16_bf16(b0, qr[d0], p0, 0, 0, 0);
        p1 = __builtin_amdgcn_mfma_f32_32x32x16_bf16(b1, qr[d0], p1, 0, 0, 0); }
}
DEVI int v_st(int k, int c) { const int kk = (k & ~0xC) | ((k & 4) << 1) | ((k & 8) >> 1); return ((kk >> 3) * 4 + (c >> 5)) * 512 + ((kk & 7) * 32 + (c & 31)) * 2; }
DEVI int v_rd_base(int lane) { return ((lane & 3) << 3) | (((lane >> 2) & 3) << 6) | (((lane >> 4) & 1) << 5) | (((lane >> 5) & 1) << 8); }
constexpr int v_rd_off(int d0, int ks, int half) { return d0 * 512 + ks * 4096 + half * 2048; }
template <int OFF> DEVI s16x4 tr_read(int vb) { s16x4 r; asm volatile("ds_read_b64_tr_b16 %0, %1 offset:%2" : "=&v"(r) : "v"(vb), "i"(OFF) : "memory"); return r; }
template <int D0> DEVI void pv_one(f32x16& od, int vb, bf16x8 pa0, bf16x8 pa1, bf16x8 pa2, bf16x8 pa3) {
    const s16x4 l0 = tr_read<v_rd_off(D0, 0, 0)>(vb), h0 = tr_read<v_rd_off(D0, 0, 1)>(vb), l1 = tr_read<v_rd_off(D0, 1, 0)>(vb), h1 = tr_read<v_rd_off(D0, 1, 1)>(vb);
    const s16x4 l2 = tr_read<v_rd_off(D0, 2, 0)>(vb), h2 = tr_read<v_rd_off(D0, 2, 1)>(vb), l3 = tr_read<v_rd_off(D0, 3, 0)>(vb), h3 = tr_read<v_rd_off(D0, 3, 1)>(vb);
    asm volatile("s_waitcnt lgkmcnt(0)" ::: "memory"); SBAR();
#define PK(L, H) (bf16x8){L[0], L[1], L[2], L[3], H[0], H[1], H[2], H[3]}
    od = __builtin_amdgcn_mfma_f32_32x32x16_bf16(pa0, PK(l0, h0), od, 0, 0, 0);
    od = __builtin_amdgcn_mfma_f32_32x32x16_bf16(pa1, PK(l1, h1), od, 0, 0, 0);
    od = __builtin_amdgcn_mfma_f32_32x32x16_bf16(pa2, PK(l2, h2), od, 0, 0, 0);
    od = __builtin_amdgcn_mfma_f32_32x32x16_bf16(pa3, PK(l3, h3), od, 0, 0, 0);
#undef PK
}
DEVI void pv_d0(f32x16* o, int vb, bf16x8 pa0, bf16x8 pa1, bf16x8 pa2, bf16x8 pa3) {
    pv_one<0>(o[0], vb, pa0, pa1, pa2, pa3); pv_one<1>(o[1], vb, pa0, pa1, pa2, pa3); pv_one<2>(o[2], vb, pa0, pa1, pa2, pa3); pv_one<3>(o[3], vb, pa0, pa1, pa2, pa3);
}
DEVI void attn_unit(int l, int unit, char* lds) {
    KPARAMS(p);
    const int tid = TIDX, wid = tid >> 6, lane = tid & 63, r32 = lane & 31, hi = lane >> 5, c = wid >> 2, wq = wid & 3;
    const bf16_t* P = (const bf16_t*)(p.ws + WS_P); const bf16_t* CKB = (const bf16_t*)(p.ws + WS_CKB); const bf16_t* CVB = (const bf16_t*)(p.ws + WS_CVB);
    const bool smp = unit < 128; const int v = unit - 128;
    const int b = smp ? unit >> 6 : v >> 4, h = smp ? (unit >> 3) & 7 : (v >> 1) & 7, qb = smp ? unit & 7 : v & 1;
    const int NTL = smp ? 24 : 4, krow0 = smp ? MC + b * DSEQ : b * SEQ, qrow0 = krow0 + qb * 128;
    char* V_lds = lds; char* K_lds = lds + 2 * SHM_V;
    float* wsm = (float*)(lds + 2 * SHM_V + 2 * SHM_K) + wid * 64; float* li_l = wsm; float* al_l = wsm + 32;
    float m_reg = -1e30f, l_reg = 0; f32x16 o[4] = {}; bf16x8 qr[4];
    { const bf16_t* Qw = P + (size_t)(qrow0 + wq * 32 + r32) * IN_W + CQ + h * 128 + c * 64 + hi * 8;
#pragma unroll
      for (int d0 = 0; d0 < 4; ++d0) qr[d0] = *reinterpret_cast<const bf16x8*>(Qw + d0 * 16); }
    const int sr = tid >> 4, sc = (tid & 15) * 8, vst0 = v_st(sr, sc), vst1 = v_st(32 + sr, sc);
    const int vb0 = (int)(uintptr_t)V_lds + v_rd_base(lane);
    struct { bf16x8 vs0, vs1, ks0, ks1; } sr_[2];
#define KVPTR(j, kp, vp, st) do { if (smp && (j) < 8) { const size_t o_ = ((size_t)((b * 2 + l) * PAST + (j) * 64)) * 1024 + h * 128; kp = CKB + o_; vp = CVB + o_; st = 1024; } \
      else { const size_t o_ = (size_t)(krow0 + ((j) - (smp ? 8 : 0)) * 64) * IN_W + h * 128; kp = P + o_ + CK; vp = P + o_ + CV; st = IN_W; } } while (0)
#define SLOAD(i, j) do { const bf16_t* kp_; const bf16_t* vp_; int st_; KVPTR(j, kp_, vp_, st_); \
      sr_[i].vs0 = *reinterpret_cast<const bf16x8*>(vp_ + (size_t)sr * st_ + sc); sr_[i].vs1 = *reinterpret_cast<const bf16x8*>(vp_ + (size_t)(32 + sr) * st_ + sc); \
      sr_[i].ks0 = *reinterpret_cast<const bf16x8*>(kp_ + (size_t)sr * st_ + sc); sr_[i].ks1 = *reinterpret_cast<const bf16x8*>(kp_ + (size_t)(32 + sr) * st_ + sc); } while (0)
#define SWRITE(bb, i) do { *(bf16x8*)(V_lds + (bb) * SHM_V + vst0) = sr_[i].vs0; *(bf16x8*)(V_lds + (bb) * SHM_V + vst1) = sr_[i].vs1; const int kc = sc * 2; \
      *(bf16x8*)(K_lds + (bb) * SHM_K + KSWZ(sr, kc)) = sr_[i].ks0; *(bf16x8*)(K_lds + (bb) * SHM_K + KSWZ(32 + sr, kc)) = sr_[i].ks1; } while (0)
#define SWAIT() asm volatile("s_waitcnt vmcnt(4)" ::: "memory")
#define RESC(a) do { if (__any((a) < 1.f)) { if (hi == 0) al_l[r32] = (a); asm volatile("s_waitcnt lgkmcnt(0)" ::: "memory"); \
      _Pragma("unroll") for (int d = 0; d < 4; ++d) _Pragma("unroll") for (int r = 0; r < 16; ++r) o[d][r] *= al_l[crow(r, hi)]; } } while (0)
    f32x16 pA0, pA1, pB0, pB1; float mnA, mnB, alA, alB; bf16x8 pa0, pa1, pa2, pa3;
    constexpr int SE = 0, SO = 1;
    SLOAD(SE, 0); asm volatile("s_waitcnt vmcnt(0)" ::: "memory"); SWRITE(0, SE); __syncthreads();
    qkt(pA0, pA1, K_lds, qr, r32, hi, c); partialSM(pA0, pA1, m_reg, mnA, alA);
    SLOAD(SO, 1); if (2 < NTL) SLOAD(SE, 2);
    SWAIT(); SWRITE(1, SO); __syncthreads();
    for (int j = 1; j + 1 < NTL; j += 2) {
        SBAR(); qkt(pB0, pB1, K_lds + SHM_K, qr, r32, hi, c);
        finishSM(pA0, pA1, alA, l_reg, pa0, pa1, pa2, pa3); SBAR();
        SLOAD(SO, j + 2); SBAR();
        pv_d0(o, vb0, pa0, pa1, pa2, pa3); partialSM(pB0, pB1, m_reg, mnB, alB);
        __syncthreads(); SWAIT(); SWRITE(0, SE);
        RESC(alB); __syncthreads();
        SBAR(); qkt(pA0, pA1, K_lds, qr, r32, hi, c);
        finishSM(pB0, pB1, alB, l_reg, pa0, pa1, pa2, pa3); SBAR();
        if (j + 3 < NTL) SLOAD(SE, j + 3); SBAR();
        pv_d0(o, vb0 + SHM_V, pa0, pa1, pa2, pa3); partialSM(pA0, pA1, m_reg, mnA, alA);
        __syncthreads(); SWAIT(); SWRITE(1, SO);
        RESC(alA); __syncthreads();
    }
    SBAR(); qkt(pB0, pB1, K_lds + SHM_K, qr, r32, hi, c);
    finishSM(pA0, pA1, alA, l_reg, pa0, pa1, pa2, pa3); SBAR();
    pv_d0(o, vb0, pa0, pa1, pa2, pa3); partialSM(pB0, pB1, m_reg, mnB, alB);
    __syncthreads(); RESC(alB);
    finishSM(pB0, pB1, alB, l_reg, pa0, pa1, pa2, pa3); SBAR();
    pv_d0(o, vb0 + SHM_V, pa0, pa1, pa2, pa3);
    KPARAMS(pe);
    const int ql = tid >> 2, sg = (tid & 3) * 32; const size_t erow = (size_t)(qrow0 + ql);
    u32x4 ag[4]; f32x4 gv[8];
    { const bf16_t* agp = (const bf16_t*)(pe.ws + WS_P) + erow * IN_W + CAG + h * 128 + sg; const float* gp = pe.subln_g + l * 128 + sg;
#pragma unroll
      for (int q4 = 0; q4 < 4; ++q4) { ag[q4] = *(const u32x4*)(agp + q4 * 8); gv[2 * q4] = *(const f32x4*)(gp + q4 * 8); gv[2 * q4 + 1] = *(const f32x4*)(gp + q4 * 8 + 4); } }
    if (hi == 0) li_l[r32] = l_reg;
    asm volatile("s_waitcnt lgkmcnt(0)" ::: "memory");
    float rli[16];
    const float lamv = (c == 1) ? *(volatile float*)(lds + LDS_QSLOT + 32) : 1.f;
#pragma unroll
    for (int r = 0; r < 16; ++r) rli[r] = __builtin_amdgcn_rcpf(li_l[crow(r, hi)]) * lamv;
    __syncthreads();
    float* X = (float*)lds;
    if (c == 1) {
#pragma unroll
        for (int r = 0; r < 16; ++r)
#pragma unroll
            for (int d0 = 0; d0 < 4; ++d0) X[(wq * 32 + crow(r, hi)) * 132 + d0 * 32 + r32] = o[d0][r] * rli[r];
    }
    __syncthreads();
    if (c == 0) {
#pragma unroll
        for (int r = 0; r < 16; ++r) {
            const int qx = wq * 32 + crow(r, hi);
#pragma unroll
            for (int d0 = 0; d0 < 4; ++d0) X[qx * 132 + d0 * 32 + r32] = o[d0][r] * rli[r] - X[qx * 132 + d0 * 32 + r32];
        }
    }
    __syncthreads();
    {
        int lq = l; asm volatile("" : "+s"(lq));
        const float post = 1.0f - lam_init_of(lq);
        f32x4 xv[8]; float ss = 0.f;
#pragma unroll
        for (int q8 = 0; q8 < 8; ++q8) { xv[q8] = *(const f32x4*)(X + ql * 132 + sg + q8 * 4); ss += xv[q8][0] * xv[q8][0] + xv[q8][1] * xv[q8][1] + xv[q8][2] * xv[q8][2] + xv[q8][3] * xv[q8][3]; }
        ss += swz_xor<1>(ss); ss += swz_xor<2>(ss);
        const float rs = rsqrtf(ss * (1.0f / 128.0f) + 1e-6f) * post;
        bf16_t* mx = (bf16_t*)(pe.ws + WS_MIX) + erow * D + h * 128 + sg;
#pragma unroll
        for (int q4 = 0; q4 < 4; ++q4) {
            const f32x4 x0 = xv[2 * q4], x1 = xv[2 * q4 + 1], g0 = gv[2 * q4], g1 = gv[2 * q4 + 1];
            float ov[8];
#pragma unroll
            for (int e = 0; e < 4; ++e) { const float a0 = __uint_as_float(ag[q4][e] << 16), a1 = __uint_as_float(ag[q4][e] & 0xffff0000u);
                const float xa = (e < 2 ? x0[2 * e] : x1[2 * e - 4]), xb = (e < 2 ? x0[2 * e + 1] : x1[2 * e - 3]), ga = (e < 2 ? g0[2 * e] : g1[2 * e - 4]), gb = (e < 2 ? g0[2 * e + 1] : g1[2 * e - 3]);
                ov[2 * e] = xa * rs * ga * (a0 * lru_fsig(a0)); ov[2 * e + 1] = xb * rs * gb * (a1 * lru_fsig(a1)); }
            u32x4 w; w.x = pk2bf(ov[0], ov[1]); w.y = pk2bf(ov[2], ov[3]); w.z = pk2bf(ov[4], ov[5]); w.w = pk2bf(ov[6], ov[7]);
            *(u32x4*)(mx + q4 * 8) = w;
        }
    }
    __syncthreads();
#undef KVPTR
#undef SLOAD
#undef SWRITE
#undef SWAIT
#undef RESC
}
}
DEVI void ph_final(const Params& p) {
    const int wid = TIDX >> 6, lane = TIDX & 63, gw = blockIdx.x * (NT / 64) + wid, NGW = gridDim.x * (NT / 64);
    for (int row = gw; row < MT; row += NGW) {
        float* xr = p.out + (size_t)row * D;
        f32x4 v[8]; float ss = 0.f;
#pragma unroll
        for (int j = 0; j < 8; ++j) { v[j] = *(const f32x4*)(xr + j * 256 + lane * 4); ss += v[j][0] * v[j][0] + v[j][1] * v[j][1] + v[j][2] * v[j][2] + v[j][3] * v[j][3]; }
        const float rs = rsqrtf(wave_sum(ss) * (1.0f / D) + 1e-6f);
        f32x4 g[8];
#pragma unroll
        for (int j = 0; j < 8; ++j) g[j] = *(const f32x4*)(p.final_g + j * 256 + lane * 4);
#pragma unroll
        for (int j = 0; j < 8; ++j) *(f32x4*)(xr + j * 256 + lane * 4) = v[j] * rs * g[j];
    }
}

namespace lru {
#define LBAR() do { asm volatile("s_waitcnt lgkmcnt(0)" ::: "memory"); __builtin_amdgcn_s_barrier(); asm volatile("" ::: "memory"); } while (0)
constexpr int L_W = 0, L_XCB = 36864, L_XCF = L_XCB + 9216, L_A = L_XCF + 64 * 68 * 4, L_B = L_A + 64 * 68 * 4, L_SEG = L_B + 64 * 68 * 4, L_C = L_SEG + 4096, L_END = L_C + 512;
DEVI float fsigmoid(float x) { return __builtin_amdgcn_rcpf(1.0f + __builtin_amdgcn_exp2f(-1.4426950408889634f * x)); }
DEVI void gate_ab(float ra, float ia, float sp8, float xc, float& a, float& bb) {
    const float r = fsigmoid(ra), ig = fsigmoid(ia), log_a = sp8 * r, x = 2.0f * log_a;
    a = __builtin_amdgcn_exp2f(1.4426950408889634f * log_a);
    const float poly = -x * (1.0f + x * (0.5f + x * (0.16666667f + x * (0.041666668f + x * 0.0083333333f))));
    const float om = (x > -0.3f) ? poly : 1.0f - __builtin_amdgcn_exp2f(1.4426950408889634f * x);
    bb = __builtin_amdgcn_sqrtf(om) * (ig * xc);
}
template <bool REV> DEVI void scan_chunk(float* AL, float* BL, float* SEG, float* Cc, int ci, int sch, int seg) {
    float av[8], bv[8];
    { float A = 1.f, H = 0.f;
#pragma unroll
      for (int k = 0; k < 8; ++k) { const int pos = seg * 8 + k, tk = REV ? 63 - pos : pos; av[k] = AL[tk * 68 + sch]; bv[k] = BL[tk * 68 + sch]; H = av[k] * H + bv[k]; A *= av[k]; }
      SEG[(seg * 64 + sch) * 2] = A; SEG[(seg * 64 + sch) * 2 + 1] = H; }
    LBAR();
    float h = Cc[(ci & 1) * 64 + sch];
    for (int s2 = 0; s2 < seg; ++s2) h = SEG[(s2 * 64 + sch) * 2] * h + SEG[(s2 * 64 + sch) * 2 + 1];
#pragma unroll
    for (int k = 0; k < 8; ++k) { const int pos = seg * 8 + k, tk = REV ? 63 - pos : pos; h = av[k] * h + bv[k]; BL[tk * 68 + sch] = h; }
    if (seg == 7) Cc[((ci + 1) & 1) * 64 + sch] = h;
    LBAR();
}
DEVI void lru_unit(int l, int unit, char* lds) {
    KPARAMS(p);
    const int tid = TIDX, wid = tid >> 6, lane = tid & 63;
    const bool smp = unit < 16; const int v = unit - 16;
    const int b = smp ? unit >> 3 : v >> 3, n = smp ? unit & 7 : v & 7, L = smp ? DSEQ : SEQ, row0 = smp ? MC + b * DSEQ : b * SEQ, nchunk = L / 64;
    const bf16_t* P = (const bf16_t*)(p.ws + WS_P); bf16_t* MIX = (bf16_t*)(p.ws + WS_MIX);
    float* HS = (float*)(p.ws + WS_HS); float* SA = (float*)(p.ws + WS_SA); float* SB = (float*)(p.ws + WS_SB);
    bf16_t* Wl = (bf16_t*)(lds + L_W); bf16_t* XCB = (bf16_t*)(lds + L_XCB); float* XCF = (float*)(lds + L_XCF);
    float* AL = (float*)(lds + L_A); float* BL = (float*)(lds + L_B); float* SEG = (float*)(lds + L_SEG); float* Cc = (float*)(lds + L_C);
    __syncthreads();
    {
        const bf16_t* src = (const bf16_t*)(p.ws + WS_WGB) + (size_t)(l * 8 + n) * 16384;
#pragma unroll
        for (int i = 0; i < 4; ++i) { const int e = (i * 512 + tid) * 8, mat = e >> 12, d = (e >> 6) & 63, c = e & 63;
            *(u32x4*)(Wl + (mat * 64 + d) * 72 + c) = *(const u32x4*)(src + e); }
    }
    const int ct = tid >> 3, c8 = (tid & 7) * 8, chg = n * 64 + c8;
    const int db = wid & 3, mh = wid >> 2, fr = lane & 15, fq = lane >> 4, gd = db * 16 + fr, gch = n * 64 + gd;
    const int sch = tid & 63, seg = tid >> 6;
    if (tid < 64) Cc[tid] = smp ? p.state_lru[((b * 2 + l) * 2 + 0) * 512 + n * 64 + tid] : 0.f;
    float bav[2], biv[2], sp8[2];
#pragma unroll
    for (int dir = 0; dir < 2; ++dir) { bav[dir] = p.lru_ba[(l * 2 + dir) * 512 + gch]; biv[dir] = p.lru_bi[(l * 2 + dir) * 512 + gch]; sp8[dir] = -8.0f * log1pf(expf(-p.lru_lam[(l * 2 + dir) * 512 + gch])); }
    f32x4 cw0[4], cw1[4], cb0, cb1;
#pragma unroll
    for (int j = 0; j < 4; ++j) { cw0[j] = *(const f32x4*)(p.lru_conv_w + (l * 4 + j) * 512 + chg); cw1[j] = *(const f32x4*)(p.lru_conv_w + (l * 4 + j) * 512 + chg + 4); }
    cb0 = *(const f32x4*)(p.lru_conv_b + l * 512 + chg); cb1 = *(const f32x4*)(p.lru_conv_b + l * 512 + chg + 4);
    u32x4 xv[4], xn[4];
#define LX_LOAD(dst, tbase) do { _Pragma("unroll") for (int j = 0; j < 4; ++j) { const int tt = (tbase) + ct + j - 2; dst[j] = (u32x4){0u, 0u, 0u, 0u}; \
        if (tt >= 0 && tt < L) dst[j] = *(const u32x4*)(P + (size_t)(row0 + tt) * IN_W + CLX + chg); } } while (0)
    LX_LOAD(xv, 0);
#pragma unroll 1
    for (int ci = 0; ci < nchunk; ++ci) {
        const int t0 = ci * 64;
        if (ci + 1 < nchunk) LX_LOAD(xn, t0 + 64);
        {
            float xc[8];
#pragma unroll
            for (int e = 0; e < 4; ++e) { xc[e] = cb0[e]; xc[4 + e] = cb1[e]; }
#pragma unroll
            for (int j = 0; j < 4; ++j) {
#pragma unroll
                for (int e = 0; e < 4; ++e) { const unsigned wd = xv[j][e]; xc[2 * e] += (e < 2 ? cw0[j][2 * e] : cw1[j][2 * e - 4]) * __uint_as_float(wd << 16); xc[2 * e + 1] += (e < 2 ? cw0[j][2 * e + 1] : cw1[j][2 * e - 3]) * __uint_as_float(wd & 0xffff0000u); }
            }
            *(f32x4*)(XCF + ct * 68 + c8) = (f32x4){xc[0], xc[1], xc[2], xc[3]}; *(f32x4*)(XCF + ct * 68 + c8 + 4) = (f32x4){xc[4], xc[5], xc[6], xc[7]};
            u32x4 w; w.x = pk2bf(xc[0], xc[1]); w.y = pk2bf(xc[2], xc[3]); w.z = pk2bf(xc[4], xc[5]); w.w = pk2bf(xc[6], xc[7]);
            *(u32x4*)(XCB + ct * 72 + c8) = w;
        }
        LBAR();
        {
            f32x4 acc[2][4];
#pragma unroll
            for (int mt = 0; mt < 2; ++mt)
#pragma unroll
                for (int g = 0; g < 4; ++g) acc[mt][g] = (f32x4){0.f, 0.f, 0.f, 0.f};
#pragma unroll
            for (int ks = 0; ks < 2; ++ks) {
                bf16x8 af[2], bfr[4];
#pragma unroll
                for (int mt = 0; mt < 2; ++mt) af[mt] = *(const bf16x8*)(XCB + (mh * 32 + mt * 16 + fr) * 72 + ks * 32 + fq * 8);
#pragma unroll
                for (int g = 0; g < 4; ++g) bfr[g] = *(const bf16x8*)(Wl + (g * 64 + gd) * 72 + ks * 32 + fq * 8);
#pragma unroll
                for (int mt = 0; mt < 2; ++mt)
#pragma unroll
                    for (int g = 0; g < 4; ++g) acc[mt][g] = __builtin_amdgcn_mfma_f32_16x16x32_bf16(af[mt], bfr[g], acc[mt][g], 0, 0, 0);
            }
#pragma unroll
            for (int mt = 0; mt < 2; ++mt)
#pragma unroll
                for (int j = 0; j < 4; ++j) {
                    const int tk = mh * 32 + mt * 16 + fq * 4 + j; const float xc = XCF[tk * 68 + gd];
                    float a, bb;
                    gate_ab(acc[mt][0][j] + bav[0], acc[mt][1][j] + biv[0], sp8[0], xc, a, bb);
                    AL[tk * 68 + gd] = a; BL[tk * 68 + gd] = bb;
                    gate_ab(acc[mt][2][j] + bav[1], acc[mt][3][j] + biv[1], sp8[1], xc, a, bb);
                    const size_t gi = (size_t)(row0 + t0 + tk) * 512 + gch; SA[gi] = a; SB[gi] = bb;
                }
        }
        LBAR();
        scan_chunk<false>(AL, BL, SEG, Cc, ci, sch, seg);
        {
            float* hs = HS + (size_t)(row0 + t0 + ct) * 512 + chg;
            *(f32x4*)hs = *(const f32x4*)(BL + ct * 68 + c8); *(f32x4*)(hs + 4) = *(const f32x4*)(BL + ct * 68 + c8 + 4);
        }
#pragma unroll
        for (int j = 0; j < 4; ++j) xv[j] = xn[j];
    }
#undef LX_LOAD
    __syncthreads();
    if (tid < 64) {
        if (!smp) p.out[OUT_ST + ((size_t)(b * 2 + l) * 2 + 0) * 512 + n * 64 + tid] = Cc[(nchunk & 1) * 64 + tid];
        Cc[tid] = smp ? p.state_lru[((b * 2 + l) * 2 + 1) * 512 + n * 64 + tid] : 0.f;
    }
    asm volatile("s_waitcnt vmcnt(0)" ::: "memory");
    __syncthreads();
    f32x4 qa[2], qb[2], qh[2], na[2], nb_[2], nh[2]; u32x4 qg, ng;
#define P2_LOAD(A_, B_, H_, G_, chunk_) do { const size_t r_ = (size_t)(row0 + (chunk_) * 64 + ct); const float* sa_ = SA + r_ * 512 + chg; const float* sb_ = SB + r_ * 512 + chg; const float* hs_ = HS + r_ * 512 + chg; \
        A_[0] = *(const f32x4*)sa_; A_[1] = *(const f32x4*)(sa_ + 4); B_[0] = *(const f32x4*)sb_; B_[1] = *(const f32x4*)(sb_ + 4); H_[0] = *(const f32x4*)hs_; H_[1] = *(const f32x4*)(hs_ + 4); \
        G_ = *(const u32x4*)(P + r_ * IN_W + CLG + chg); } while (0)
    P2_LOAD(qa, qb, qh, qg, nchunk - 1);
#pragma unroll 1
    for (int ci = 0; ci < nchunk; ++ci) {
        const int t0 = (nchunk - 1 - ci) * 64; const size_t row = (size_t)(row0 + t0 + ct);
        if (ci + 1 < nchunk) P2_LOAD(na, nb_, nh, ng, nchunk - 2 - ci);
        *(f32x4*)(AL + ct * 68 + c8) = qa[0]; *(f32x4*)(AL + ct * 68 + c8 + 4) = qa[1];
        *(f32x4*)(BL + ct * 68 + c8) = qb[0]; *(f32x4*)(BL + ct * 68 + c8 + 4) = qb[1];
        LBAR();
        scan_chunk<true>(AL, BL, SEG, Cc, ci, sch, seg);
        {
            const f32x4 h0 = *(const f32x4*)(BL + ct * 68 + c8), h1 = *(const f32x4*)(BL + ct * 68 + c8 + 4);
            float o[8];
#pragma unroll
            for (int e = 0; e < 4; ++e) { const float s0 = (e < 2 ? qh[0][2 * e] + h0[2 * e] : qh[1][2 * e - 4] + h1[2 * e - 4]), s1 = (e < 2 ? qh[0][2 * e + 1] + h0[2 * e + 1] : qh[1][2 * e - 3] + h1[2 * e - 3]);
                const float g0 = __uint_as_float(qg[e] << 16), g1 = __uint_as_float(qg[e] & 0xffff0000u);
                o[2 * e] = s0 * g0 * fsigmoid(g0); o[2 * e + 1] = s1 * g1 * fsigmoid(g1); }
            u32x4 w; w.x = pk2bf(o[0], o[1]); w.y = pk2bf(o[2], o[3]); w.z = pk2bf(o[4], o[5]); w.w = pk2bf(o[6], o[7]);
            *(u32x4*)(MIX + row * D + 1024 + chg) = w;
        }
        LBAR();
#pragma unroll
        for (int e = 0; e < 2; ++e) { qa[e] = na[e]; qb[e] = nb_[e]; qh[e] = nh[e]; }
        qg = ng;
    }
#undef P2_LOAD
    if (!smp && tid < 64) p.out[OUT_ST + ((size_t)(b * 2 + l) * 2 + 1) * 512 + n * 64 + tid] = Cc[(nchunk & 1) * 64 + tid];
    __syncthreads();
}
}

namespace hy {
constexpr int L_ZERO = 36864, L_YT = 40960, L_R = 110592;
template <bool SMP> DEVI void hy_unit_t(int l, int unit, char* lds) {
    constexpr int NCH = SMP ? 4 : 8, NSEQ = SMP ? 2 : 8, L = SMP ? DSEQ : SEQ, NBLK = L / 32, SEQSTRIDE = L * 2 + (L >> 7) * 16;
    KPARAMS(p);
    const int tid = TIDX, wid = tid >> 6, lane = tid & 63, r32 = lane & 31, hi = lane >> 5;
    const int c0 = SMP ? unit * 4 : (unit >> 2) * 8, row0 = SMP ? MC : (unit & 3) * 2048;
    const bf16_t* PHY = (const bf16_t*)(p.ws + WS_PH); bf16_t* MIX = (bf16_t*)(p.ws + WS_MIX);
    char* VT = lds; float* Yt = (float*)(lds + L_YT);
    const int tok0 = tid * 4, sq = tok0 / L, s0 = tok0 % L;
    __syncthreads();
    if (tid < 4) ((unsigned*)(lds + L_ZERO))[tid] = 0u;
    {
        const bf16_t* GSu = (const bf16_t*)(p.ws + WS_GS) + (size_t)l * GS_PER_LAYER + (SMP ? GS_L256 : 0) + (size_t)c0 * 2 * L;
#pragma unroll
        for (int q = 0; q < (NCH * 2 * L / 8) / NT; ++q) *(u32x4*)(lds + L_R + (q * NT + tid) * 16) = *(const u32x4*)(GSu + (size_t)(q * NT + tid) * 8);
    }
    {
        float xh[6][NCH], x1[6][NCH];
#pragma unroll
        for (int rr = 0; rr < 6; ++rr) {
            const int ss = s0 + rr - 1; const bool ok = ss >= 0 && ss < L;
            const bf16_t* src = PHY + ((size_t)(c0 >> 3) * MT + (row0 + tok0 + rr - 1)) * 8 + (c0 & 7);
            constexpr size_t KIND = (size_t)64 * MT * 8;
            if (SMP) { uint2 a = make_uint2(0u, 0u), b = a; if (ok) { a = *(const uint2*)src; b = *(const uint2*)(src + KIND); }
                xh[rr][0] = __uint_as_float(a.x << 16); xh[rr][1] = __uint_as_float(a.x & 0xffff0000u); xh[rr][2] = __uint_as_float(a.y << 16); xh[rr][3] = __uint_as_float(a.y & 0xffff0000u);
                x1[rr][0] = __uint_as_float(b.x << 16); x1[rr][1] = __uint_as_float(b.x & 0xffff0000u); x1[rr][2] = __uint_as_float(b.y << 16); x1[rr][3] = __uint_as_float(b.y & 0xffff0000u); }
            else { u32x4 a = {0u, 0u, 0u, 0u}, b = a; if (ok) { a = *(const u32x4*)src; b = *(const u32x4*)(src + KIND); }
#pragma unroll
                for (int e = 0; e < 4; ++e) { xh[rr][2 * e] = __uint_as_float(a[e] << 16); xh[rr][2 * e + 1] = __uint_as_float(a[e] & 0xffff0000u); x1[rr][2 * e] = __uint_as_float(b[e] << 16); x1[rr][2 * e + 1] = __uint_as_float(b[e] & 0xffff0000u); } }
        }
#pragma unroll
        for (int c = 0; c < NCH; ++c) {
            const int ch = c0 + c;
            const float bh = p.hy_conv_b[l * 1536 + ch], b1 = p.hy_conv_b[l * 1536 + 512 + ch];
            const float wh0 = p.hy_conv_w[(l * 3 + 0) * 1536 + ch], wh1 = p.hy_conv_w[(l * 3 + 1) * 1536 + ch], wh2 = p.hy_conv_w[(l * 3 + 2) * 1536 + ch];
            const float w10 = p.hy_conv_w[(l * 3 + 0) * 1536 + 512 + ch], w11 = p.hy_conv_w[(l * 3 + 1) * 1536 + 512 + ch], w12 = p.hy_conv_w[(l * 3 + 2) * 1536 + 512 + ch];
            float v[4];
#pragma unroll
            for (int e = 0; e < 4; ++e) v[e] = (bh + wh0 * xh[e][c] + wh1 * xh[e + 1][c] + wh2 * xh[e + 2][c]) * (b1 + w10 * x1[e][c] + w11 * x1[e + 1][c] + w12 * x1[e + 2][c]);
            *(uint2*)(VT + (c * NSEQ + sq) * SEQSTRIDE + s0 * 2 + (s0 >> 7) * 16) = make_uint2(pk2bf(v[0], v[1]), pk2bf(v[2], v[3]));
        }
    }
    __syncthreads();
    typedef typename std::conditional<SMP, uint2, u32x4>::type raw_t;
    raw_t xr[6], gr[4];
#pragma unroll
    for (int rr = 0; rr < 6; ++rr) { const int ss = s0 + rr - 1; xr[rr] = raw_t{}; if (ss >= 0 && ss < L) xr[rr] = *(const raw_t*)(PHY + ((size_t)(128 + (c0 >> 3)) * MT + (row0 + tok0 + rr - 1)) * 8 + (c0 & 7)); }
#pragma unroll
    for (int e = 0; e < 4; ++e) gr[e] = *(const raw_t*)(PHY + ((size_t)(192 + (c0 >> 3)) * MT + (row0 + tok0 + e)) * 8 + (c0 & 7));
    {
        const int wch = SMP ? wid >> 1 : wid;
        const unsigned* Rd = (const unsigned*)(lds + L_R) + wch * L;
        constexpr int NTW = SMP ? 1 : 2;
        att::f32x16 acc[NTW];
#pragma unroll
        for (int nt = 0; nt < NTW; ++nt) acc[nt] = att::f32x16{};
        int vbase[NTW], iblk[NTW];
#pragma unroll
        for (int nt = 0; nt < NTW; ++nt) {
            const int colg = SMP ? (wid & 1) * 32 + r32 : nt * 32 + r32, seq = SMP ? colg >> 5 : colg >> 3;
            iblk[nt] = SMP ? colg & 31 : colg & 7; vbase[nt] = (wch * NSEQ + seq) * SEQSTRIDE + hi * 16;
        }
        const int abase = L - 1 - r32 + 8 * hi;
        const unsigned ash = (unsigned)(abase & 1) * 16u;
#pragma unroll 4
        for (int k = -(NBLK - 1); k <= NBLK - 1; ++k) {
#pragma unroll
            for (int ks = 0; ks < 2; ++ks) {
                const unsigned* dp = Rd + ((abase - 32 * k + 16 * ks) >> 1);
                const unsigned d0 = dp[0], d1 = dp[1], d2 = dp[2], d3 = dp[3], d4 = dp[4];
                u32x4 aw; aw.x = __builtin_amdgcn_alignbit(d1, d0, ash); aw.y = __builtin_amdgcn_alignbit(d2, d1, ash); aw.z = __builtin_amdgcn_alignbit(d3, d2, ash); aw.w = __builtin_amdgcn_alignbit(d4, d3, ash);
                const bf16x8 A = __builtin_bit_cast(bf16x8, aw);
#pragma unroll
                for (int nt = 0; nt < NTW; ++nt) {
                    const int src = iblk[nt] - k; const bool ok = src >= 0 && src < NBLK;
                    const int sidx = 32 * src + 16 * ks;
                    const int off = ok ? vbase[nt] + sidx * 2 + (sidx >> 7) * 16 : L_ZERO;
                    const bf16x8 B = *(const bf16x8*)(lds + off);
                    acc[nt] = __builtin_amdgcn_mfma_f32_32x32x16_bf16(A, B, acc[nt], 0, 0, 0);
                }
            }
        }
#pragma unroll
        for (int nt = 0; nt < NTW; ++nt) {
            const int colg = SMP ? (wid & 1) * 32 + r32 : nt * 32 + r32;
#pragma unroll
            for (int r = 0; r < 16; ++r) Yt[(wch * 64 + colg) * 33 + att::crow(r, hi)] = acc[nt][r];
        }
    }
    __syncthreads();
    {
        float x0[6][NCH];
#pragma unroll
        for (int rr = 0; rr < 6; ++rr) {
            if constexpr (SMP) { const uint2 a = xr[rr];
                x0[rr][0] = __uint_as_float(a.x << 16); x0[rr][1] = __uint_as_float(a.x & 0xffff0000u); x0[rr][2] = __uint_as_float(a.y << 16); x0[rr][3] = __uint_as_float(a.y & 0xffff0000u); }
            else { const u32x4 a = xr[rr];
#pragma unroll
                for (int e = 0; e < 4; ++e) { x0[rr][2 * e] = __uint_as_float(a[e] << 16); x0[rr][2 * e + 1] = __uint_as_float(a[e] & 0xffff0000u); } }
        }
        float w0[NCH], w1[NCH], w2[NCH], bb[NCH];
#pragma unroll
        for (int c = 0; c < NCH; ++c) { const int ch = 1024 + c0 + c; bb[c] = p.hy_conv_b[l * 1536 + ch]; w0[c] = p.hy_conv_w[(l * 3 + 0) * 1536 + ch]; w1[c] = p.hy_conv_w[(l * 3 + 1) * 1536 + ch]; w2[c] = p.hy_conv_w[(l * 3 + 2) * 1536 + ch]; }
        const int blk = tok0 >> 5, a0 = tok0 & 31;
#pragma unroll
        for (int e = 0; e < 4; ++e) {
            const size_t row = (size_t)(row0 + tok0 + e);
            float o[NCH];
            if constexpr (SMP) { const uint2 g = gr[e]; const float hg[4] = {__uint_as_float(g.x << 16), __uint_as_float(g.x & 0xffff0000u), __uint_as_float(g.y << 16), __uint_as_float(g.y & 0xffff0000u)};
#pragma unroll
                for (int c = 0; c < NCH; ++c) o[c] = (bb[c] + w0[c] * x0[e][c] + w1[c] * x0[e + 1][c] + w2[c] * x0[e + 2][c]) * Yt[(c * 64 + blk) * 33 + a0 + e] * (hg[c] * lru::fsigmoid(hg[c]));
                *(uint2*)(MIX + row * D + 1536 + c0) = make_uint2(pk2bf(o[0], o[1]), pk2bf(o[2], o[3])); }
            else { const u32x4 g = gr[e];
#pragma unroll
                for (int c = 0; c < NCH; ++c) { const float hg = (c & 1) ? __uint_as_float(g[c >> 1] & 0xffff0000u) : __uint_as_float(g[c >> 1] << 16);
                    o[c] = (bb[c] + w0[c] * x0[e][c] + w1[c] * x0[e + 1][c] + w2[c] * x0[e + 2][c]) * Yt[(c * 64 + blk) * 33 + a0 + e] * (hg * lru::fsigmoid(hg)); }
                u32x4 w; w.x = pk2bf(o[0], o[1]); w.y = pk2bf(o[2], o[3]); w.z = pk2bf(o[4], o[5]); w.w = pk2bf(o[6], o[7]);
                *(u32x4*)(MIX + row * D + 1536 + c0) = w; }
        }
    }
}
DEVI void hy_unit(int l, int unit, char* lds) { if (unit < 128) hy_unit_t<true>(l, unit, lds); else hy_unit_t<false>(l, unit - 128, lds); }
}

constexpr int Q_N0 = 640, Q_N1 = 272, Q_N2 = 384;
DEVI void ph_mix(const Params& p, int l, char* lds) {
    const int tid = TIDX, lane = tid & 63;
    const float d1 = wave_sum(p.lam_q1[l * 64 + lane] * p.lam_k1[l * 64 + lane]), d2 = wave_sum(p.lam_q2[l * 64 + lane] * p.lam_k2[l * 64 + lane]);
    if (tid == 0) *(volatile float*)(lds + LDS_QSLOT + 32) = expf(d1) - expf(d2) + lam_init_of(l);
    unsigned* qctr = (unsigned*)(p.ws + WS_CTL) + 1024 + 256 * l;
    volatile int* slot = (volatile int*)(lds + LDS_QSLOT);
    const int pos = (int)(blockIdx.x >> 3);
    int type = pos < 18 ? 0 : (pos < 26 ? 1 : 2), tries = 0;
    for (;;) {
        const int nq = type == 0 ? Q_N0 : (type == 1 ? Q_N1 : Q_N2);
        __syncthreads();
        if (tid == 0) *slot = (int)__hip_atomic_fetch_add(qctr + 64 * type, 1u, __ATOMIC_RELAXED, __HIP_MEMORY_SCOPE_AGENT);
        __syncthreads();
        const int it = __builtin_amdgcn_readfirstlane(*slot);
        if (it >= nq) { if (++tries == 3) break; type = type == 2 ? 0 : type + 1; continue; }
        if (type == 0) att::attn_unit(l, it, lds);
        else if (type == 1) lru::lru_unit(l, it, lds);
        else hy::hy_unit(l, it, lds);
    }
}

#define XB_TMO      128
#define XB_XCNT(j)  (256  + 64 * (j))
#define XB_XSUB(j)  (1280 + 64 * (j))
#define XB_XGEN(j)  (2304 + 64 * (j))
#define XB_TOP      3328
#define XB_TOPGEN   3392
#define XCD_BAR_WORDS 3456
#define XB_SPIN_CAP (1u << 18)
DEVI unsigned xb_ld(unsigned* p)              { return __hip_atomic_load(p, __ATOMIC_RELAXED, __HIP_MEMORY_SCOPE_AGENT); }
DEVI unsigned xb_add(unsigned* p, unsigned v) { return __hip_atomic_fetch_add(p, v, __ATOMIC_RELAXED, __HIP_MEMORY_SCOPE_AGENT); }
DEVI unsigned xb_xcc_id() { return (unsigned)__builtin_amdgcn_s_getreg((3 << 11) | 20) & 0xFu; }
#define XB_SPIN(cond, bar) do { unsigned _sp = 0; while (cond) { __builtin_amdgcn_s_sleep(1); \
    if ((++_sp & 255u) == 0u) { if (xb_ld(&(bar)[XB_TMO])) break; if (_sp > XB_SPIN_CAP) { atomicAdd(&(bar)[XB_TMO], 1u); break; } } } } while (0)
struct XcdBarrier { unsigned* bar; unsigned x; volatile LAS unsigned* st; };
DEVI XcdBarrier xcd_barrier_post(unsigned* bar, volatile LAS unsigned* st) {
    XcdBarrier b; b.bar = bar; b.x = xb_xcc_id(); b.st = st;
    if (threadIdx.x == 0) (void)xb_add(&bar[XB_XCNT(b.x)], 1u);
    return b;
}
DEVI void xcd_barrier_complete(unsigned* bar, unsigned x, unsigned& nloc, unsigned& nx) {
    const unsigned G = gridDim.x * gridDim.y * gridDim.z;
    unsigned sum, cnt, mine, sp = 0u;
    for (;;) {
        sum = 0u; cnt = 0u; mine = 0u;
#pragma unroll
        for (unsigned j = 0; j < 16; ++j) { const unsigned c = xb_ld(&bar[XB_XCNT(j)]); sum += c; cnt += (c > 0u) ? 1u : 0u; mine = (j == x) ? c : mine; }
        if (sum == G) break;
        __builtin_amdgcn_s_sleep(1);
        if ((++sp & 255u) == 0u) { if (xb_ld(&bar[XB_TMO])) break; if (sp > XB_SPIN_CAP) { atomicAdd(&bar[XB_TMO], 1u); break; } }
    }
    nloc = mine > 0u ? mine : 1u; nx = cnt > 0u ? cnt : 1u;
}
DEVI void xcd_barrier(const XcdBarrier& b) {
    asm volatile("s_waitcnt vmcnt(0)" ::: "memory");
    __syncthreads();
    if (threadIdx.x == 0) {
        unsigned* bar = b.bar;
        __builtin_amdgcn_s_waitcnt(0);
        unsigned nloc = b.st[0], nx = b.st[1];
        if (nloc == 0u) { xcd_barrier_complete(bar, b.x, nloc, nx); b.st[0] = nloc; b.st[1] = nx; }
        const unsigned old = xb_add(&bar[XB_XSUB(b.x)], 1u);
        const unsigned gen = old / nloc;
        if (old + 1u == (gen + 1u) * nloc) {
            __builtin_amdgcn_fence(__ATOMIC_RELEASE, "agent");
            asm volatile("s_waitcnt vmcnt(0)" ::: "memory");
            const unsigned og = xb_add(&bar[XB_TOP], 1u);
            const unsigned tg = og / nx;
            if (og + 1u == (tg + 1u) * nx) xb_add(&bar[XB_TOPGEN], 1u);
            else XB_SPIN(xb_ld(&bar[XB_TOPGEN]) == tg, bar);
            __builtin_amdgcn_fence(__ATOMIC_ACQUIRE, "agent");
            xb_add(&bar[XB_XGEN(b.x)], 1u);
            asm volatile("s_waitcnt vmcnt(0)" ::: "memory");
        } else {
            XB_SPIN(xb_ld(&bar[XB_XGEN(b.x)]) == gen, bar);
            __builtin_amdgcn_fence(__ATOMIC_ACQUIRE, "agent");
            asm volatile("s_waitcnt vmcnt(0)" ::: "memory");
        }
    }
    __syncthreads();
}

#if defined(__HIP_DEVICE_COMPILE__)
#define PH(call) do { const Params p = *kparams(); call; } while (0)
#else
#define PH(call) do { const Params& p = p_; call; } while (0)
#endif
__global__ void __launch_bounds__(NT, 2) mega(Params p_) {
    extern __shared__ __attribute__((aligned(16))) char lds[];
    volatile LAS unsigned* bst = (volatile LAS unsigned*)(lds + LDS_QSLOT + 16);
    if (threadIdx.x == 0) { bst[0] = 0u; bst[1] = 0u; }
    if ((threadIdx.x & 63) == 0) ((volatile LAS int*)(lds + LDS_WTAB))[(unsigned)__builtin_amdgcn_s_getreg((5 << 11) | 4) & 63u] = threadIdx.x >> 6;
    __syncthreads();
#if defined(__HIP_DEVICE_COMPILE__)
    { const Params p = *kparams(); (void)xcd_barrier_post((unsigned*)(p.ws + WS_CTL) + 4096, bst); }
#define GSYNC() do { const Params p = *kparams(); XcdBarrier xb_; xb_.bar = (unsigned*)(p.ws + WS_CTL) + 4096; xb_.x = xb_xcc_id(); xb_.st = (volatile LAS unsigned*)(lds + LDS_QSLOT + 16); xcd_barrier(xb_); } while (0)
#else
#define GSYNC() do { } while (0)
#endif
    PH(ph_prep(p, lds));
    if (p_.out == nullptr) cooperative_groups::this_grid().sync();
    GSYNC();
#define LAYER(l) do { PH(ph_norm(p, l)); GSYNC(); PH(ph_gemm_in(p, l, lds)); PH(ph_filler(p, lds, (l) == 0 ? 0 : 2)); GSYNC(); PH(ph_mix(p, l, lds)); if ((l) == 0) PH(ph_filler(p, lds, 1)); GSYNC(); PH(ph_gemm_out(p, l, lds)); if ((l) == 0) PH(ph_filler(p, lds, 1)); GSYNC(); } while (0)
    LAYER(0);
    LAYER(1);
    PH(ph_final(p));
}

extern "C" void kernel_launch(void* const* d_in, const int* in_sizes, int n_in, void* d_out, int out_size, void* d_ws, size_t ws_size, hipStream_t stream) {
    static int grid_blocks = 0;
    if (grid_blocks == 0) {
        if (n_in != 33 || ws_size < WS_END) { fprintf(stderr, "kernel_launch: n_in %d ws %zu need %zu\n", n_in, ws_size, (size_t)WS_END); grid_blocks = -1; return; }
        if (hipFuncSetAttribute((const void*)mega, hipFuncAttributeMaxDynamicSharedMemorySize, LDS_TOTAL) != hipSuccess) { fprintf(stderr, "hipFuncSetAttribute failed\n"); grid_blocks = -1; return; }
        int dev = 0, cus = 0, per_cu = 0;
        (void)hipGetDevice(&dev); (void)hipDeviceGetAttribute(&cus, hipDeviceAttributeMultiprocessorCount, dev);
        (void)hipOccupancyMaxActiveBlocksPerMultiprocessor(&per_cu, (const void*)mega, NT, LDS_TOTAL);
        if (per_cu < 1) { fprintf(stderr, "occupancy query says %d blocks per CU\n", per_cu); grid_blocks = -1; return; }
        grid_blocks = cus;
    }
    if (grid_blocks < 0) return;
    Params p{};
    const float** pp = (const float**)&p;
    for (int i = 0; i < 33; ++i) pp[i] = (const float*)d_in[i];
    p.out = (float*)d_out; p.ws = (unsigned char*)d_ws;
    (void)hipMemsetAsync((char*)d_ws + WS_CTL, 0, 65536 + MOD_BYTES, stream);
    void* args[] = {&p};
    const hipError_t e = hipLaunchCooperativeKernel((const void*)mega, dim3(grid_blocks), dim3(NT), args, LDS_TOTAL, stream);
    if (e != hipSuccess) fprintf(stderr, "launch failed: %s (grid %d)\n", hipGetErrorString(e), grid_blocks);
}
```

```cpp
#include <hip/hip_runtime.h>
#include <hip/hip_cooperative_groups.h>
#include <cstdint>
#include <cstdio>
#include <type_traits>

#define DEVI __device__ __forceinline__
typedef unsigned short bf16_t;
using bf16x8 = __attribute__((ext_vector_type(8))) short;
using f32x4 = __attribute__((ext_vector_type(4))) float;

constexpr int D = 2048, NB = 32, SEQ = 256, DEPTH = 2, DB = 2, DSEQ = 1024, PAST = 512;
constexpr int NH = 8, IN_W = 7168;
constexpr int MC = NB * SEQ, MS = DB * DSEQ, MT = MC + MS;
constexpr int CQ = 0, CK = 1024, CV = 2048, CAG = 3072, CLX = 4096, CLG = 4608, CHV = 5120, CHX1 = 5632, CHX0 = 6144, CHG = 6656;
constexpr int NT = 512;

constexpr size_t OUT_YP = 0, OUT_YS = (size_t)MC * D, OUT_K = (size_t)MT * D, OUT_V = OUT_K + (size_t)NB * DEPTH * SEQ * 1024,
                 OUT_ST = OUT_V + (size_t)NB * DEPTH * SEQ * 1024;

constexpr size_t WS_CTL = 0;
constexpr size_t WS_MOD = 65536;
constexpr size_t MOD_BYTES = (size_t)2 * 3 * 6144 * 4;
constexpr size_t WS_SS = WS_MOD + MOD_BYTES;
constexpr size_t WS_SW = WS_SS + (size_t)MT * 4;
constexpr size_t WS_SS2 = WS_SW + (size_t)3 * IN_W * 4;
constexpr size_t ZERO_BYTES = 65536 + MOD_BYTES + (size_t)MT * 4 + (size_t)3 * IN_W * 4 + (size_t)MT * 4;
constexpr size_t WS_ROPE = WS_SS2 + (size_t)MT * 4;
constexpr size_t WS_FILT = WS_ROPE + 2 * 1024 * 32 * 4;
constexpr size_t FILT_PER_LAYER = (size_t)2 * 256 * 512 + (size_t)2 * 1024 * 512;
constexpr size_t WS_CKB = WS_FILT + 2 * FILT_PER_LAYER * 4;
constexpr size_t CACHE_ELEMS = (size_t)DB * DEPTH * PAST * 1024;
constexpr size_t WS_CVB = WS_CKB + CACHE_ELEMS * 2;
constexpr size_t WS_WGB = WS_CVB + CACHE_ELEMS * 2;
constexpr size_t WS_WINT = WS_WGB + (size_t)2 * 8 * 2 * 2 * 64 * 64 * 2;
constexpr size_t WS_WOUTT = WS_WINT + (size_t)2 * IN_W * D * 2;
constexpr size_t WS_H = WS_WOUTT + (size_t)2 * D * D * 2;
constexpr size_t WS_P = WS_H + (size_t)MT * D * 2;
constexpr size_t WS_MIX = WS_P + (size_t)MT * IN_W * 2;
constexpr size_t SCR1 = (size_t)MT * 512 * 4;
constexpr size_t WS_HS = WS_MIX + (size_t)MT * D * 2;
constexpr size_t WS_SA = WS_HS + SCR1, WS_SB = WS_SA + SCR1;
constexpr size_t WS_GS = WS_SB + SCR1;
constexpr size_t GS_L256 = (size_t)512 * 512, GS_PER_LAYER = GS_L256 + (size_t)512 * 2048;
constexpr size_t WS_PH = WS_GS + 2 * GS_PER_LAYER * 2;
constexpr size_t WS_XB2 = WS_PH + (size_t)MT * 2048 * 2;
constexpr int XB_SPLIT = IN_W;
constexpr size_t WS_END = WS_XB2 + (size_t)(MT - XB_SPLIT) * D * 2;

struct Params {
    const float *x_prompt, *x_sample, *cache_k, *cache_v, *state_lru, *c, *c_ctx, *norm_g, *w_ada, *b_ada, *w_in, *w_out,
        *lam_q1, *lam_k1, *lam_q2, *lam_k2, *subln_g, *lru_conv_w, *lru_conv_b, *lru_wa, *lru_ba, *lru_wi, *lru_bi, *lru_lam,
        *hy_conv_w, *hy_conv_b, *hy_w1, *hy_b1, *hy_w2, *hy_b2, *hy_w3, *hy_d, *final_g;
    float* out; unsigned char* ws;
};

#define LAS __attribute__((address_space(3)))
constexpr int LDS_QSLOT = 131072, LDS_WTAB = LDS_QSLOT + 64, LDS_TOTAL = LDS_QSLOT + 64 + 256;
DEVI char* dyn_lds() { extern __shared__ __attribute__((aligned(16))) char lds_dyn_[]; return lds_dyn_; }
DEVI int opaque_tid() {
    const unsigned hw = (unsigned)__builtin_amdgcn_s_getreg((5 << 11) | 4) & 63u;
    int wv = ((volatile LAS int*)(dyn_lds() + LDS_WTAB))[hw];
    wv = __builtin_amdgcn_readfirstlane(wv);
    int lane; asm volatile("v_mbcnt_lo_u32_b32 %0, -1, 0\n\tv_mbcnt_hi_u32_b32 %0, -1, %0" : "=v"(lane));
    return wv * 64 + lane;
}
#define TIDX opaque_tid()
typedef const __attribute__((address_space(4))) Params* KP;
DEVI KP kparams() { KP k = (KP)__builtin_amdgcn_kernarg_segment_ptr(); asm volatile("" : "+s"(k)); return k; }
#if defined(__HIP_DEVICE_COMPILE__)
#define KPARAMS(name) const Params name = *kparams()
#else
#define KPARAMS(name) const Params name{}
#endif
DEVI bf16_t f2bf(float f) { unsigned u = __float_as_uint(f); u += 0x7fffu + ((u >> 16) & 1u); return (bf16_t)(u >> 16); }
typedef unsigned u32x4 __attribute__((ext_vector_type(4)));
typedef __bf16 bf16x2_t __attribute__((ext_vector_type(2)));
typedef float f32x2_t __attribute__((ext_vector_type(2)));
DEVI unsigned pk2bf(float lo, float hi) { const f32x2_t v = {lo, hi}; return __builtin_bit_cast(unsigned, __builtin_convertvector(v, bf16x2_t)); }
DEVI float bf2f(bf16_t h) { return __uint_as_float(((unsigned)h) << 16); }
DEVI float silu_f(float x) { return x / (1.f + expf(-x)); }
DEVI float sigmoid_f(float x) { return 1.f / (1.f + expf(-x)); }
DEVI float lru_fsig(float x) { return __builtin_amdgcn_rcpf(1.0f + __builtin_amdgcn_exp2f(-1.4426950408889634f * x)); }
template <int K> DEVI float swz_xor(float v) { return __int_as_float(__builtin_amdgcn_ds_swizzle(__float_as_int(v), 0x1f | (K << 10))); }
DEVI float half_sum(float v) { v += swz_xor<1>(v); v += swz_xor<2>(v); v += swz_xor<4>(v); v += swz_xor<8>(v); v += swz_xor<16>(v); return v; }
DEVI float wave_sum(float v) { v = half_sum(v); auto rr = __builtin_amdgcn_permlane32_swap(__float_as_uint(v), __float_as_uint(v), false, false); return __uint_as_float(rr[0]) + __uint_as_float(rr[1]); }
DEVI int cond_of_row(int row) { return row < MC ? 0 : 1 + (row - MC) / DSEQ; }
DEVI bf16_t* xb_rows(unsigned char* ws, int row) { return row < XB_SPLIT ? (bf16_t*)(ws + WS_WINT) + (size_t)row * D : (bf16_t*)(ws + WS_XB2) + (size_t)(row - XB_SPLIT) * D; }
DEVI float lam_init_of(int l) { return l == 0 ? 0.2f : (0.8f - 0.6f * 0.74081822068171786607f); }

struct TrItem { const float* W; bf16_t* WT; int N, k0, n0; const float* shift; float* sw; };
DEVI TrItem tr_decode(const Params& p, int r) {
    TrItem it; it.shift = nullptr; it.sw = nullptr;
    if (r >= 1792 && r < 3584) { it.shift = (const float*)(p.ws + WS_MOD) + (size_t)3 * 6144; it.sw = (float*)(p.ws + WS_SW); }
    if (r < 3584) { const int l = r / 1792, q = r % 1792; it.W = p.w_in + (size_t)l * D * IN_W; it.WT = (bf16_t*)(p.ws + WS_WINT) + (size_t)l * IN_W * D; it.N = IN_W; it.k0 = (q / 56) * 64; it.n0 = (q % 56) * 128; }
    else { const int r2 = r - 3584, l = r2 / 512, q = r2 % 512; it.W = p.w_out + (size_t)l * D * D; it.WT = (bf16_t*)(p.ws + WS_WOUTT) + (size_t)l * D * D; it.N = D; it.k0 = (q / 16) * 64; it.n0 = (q % 16) * 128; }
    return it;
}
DEVI void tr_load(const TrItem& it, int t, f32x4 (&r)[4]) {
#pragma unroll
    for (int i = 0; i < 4; ++i) { const int idx = i * 512 + t, row = idx >> 5, c4 = idx & 31; r[i] = *(const f32x4*)(it.W + (size_t)(it.k0 + row) * it.N + it.n0 + c4 * 4); }
}
DEVI void tr_store(const TrItem& it, int t, const f32x4 (&r)[4], float* tile  ) {
#pragma unroll
    for (int i = 0; i < 4; ++i) { const int idx = i * 512 + t, row = idx >> 5, c4 = idx & 31;
#pragma unroll
        for (int e = 0; e < 4; ++e) tile[row * 129 + c4 * 4 + e] = r[i][e]; }
    __syncthreads();
#pragma unroll
    for (int j = 0; j < 2; ++j) { const int o = j * 512 + t, kg = o & 7, n = o >> 3; float v[8];
#pragma unroll
        for (int e = 0; e < 8; ++e) v[e] = tile[(kg * 8 + e) * 129 + n];
        u32x4 w; w.x = pk2bf(v[0], v[1]); w.y = pk2bf(v[2], v[3]); w.z = pk2bf(v[4], v[5]); w.w = pk2bf(v[6], v[7]);
        *(u32x4*)(it.WT + (size_t)(it.n0 + n) * D + it.k0 + kg * 8) = w; }
    if (it.shift != nullptr && t < 384) {
        const int c = t >> 7, n = t & 127; const float* sh = it.shift + (size_t)c * 6144 + it.k0; float a = 0.f;
#pragma unroll
        for (int k4 = 0; k4 < 16; ++k4) { const f32x4 s = *(const f32x4*)(sh + k4 * 4);
#pragma unroll
            for (int e = 0; e < 4; ++e) a += s[e] * tile[(k4 * 4 + e) * 129 + n]; }
        atomicAdd(it.sw + (size_t)c * IN_W + it.n0 + n, a);
    }
    __syncthreads();
}
DEVI void sw_item(const Params& p, int item, float* sc  ) {
    const int nb = item >> 3, kc = item & 7, t = TIDX;
    const float* MOD = (const float*)(p.ws + WS_MOD);
    __syncthreads();
    for (int i = t; i < 768; i += NT) sc[i] = MOD[(size_t)(3 + (i >> 8)) * 6144 + kc * 256 + (i & 255)];
    __syncthreads();
    const int n = nb * 256 + (t & 255), kh = t >> 8;
    const float* w = p.w_in + ((size_t)D + kc * 256 + kh * 128) * IN_W + n;
    float a0 = 0.f, a1 = 0.f, a2 = 0.f;
#pragma unroll 16
    for (int kk = 0; kk < 128; ++kk) { const float wv = w[(size_t)kk * IN_W]; a0 += sc[kh * 128 + kk] * wv; a1 += sc[256 + kh * 128 + kk] * wv; a2 += sc[512 + kh * 128 + kk] * wv; }
    float* SW = (float*)(p.ws + WS_SW);
    atomicAdd(SW + n, a0); atomicAdd(SW + IN_W + n, a1); atomicAdd(SW + 2 * IN_W + n, a2);
}
DEVI void mods_item(const Params& p, int item, float* sc  ) {
    const int l = item / 96, kc = (item / 3) % 32, nb = item % 3, t = TIDX;
    float* MOD = (float*)(p.ws + WS_MOD);
    if (t < 192) { const int j = t >> 6, kk = t & 63, k = kc * 64 + kk; const float cv = (j == 0) ? p.c_ctx[k] : p.c[(j - 1) * D + k]; sc[j * 64 + kk] = silu_f(cv); }
    __syncthreads();
    const int n = nb * 2048 + t * 4; f32x4 a0 = {0.f, 0.f, 0.f, 0.f}, a1 = a0, a2 = a0;
    const float* w = p.w_ada + ((size_t)l * D + kc * 64) * 6144 + n;
#pragma unroll 16
    for (int kk = 0; kk < 64; ++kk) { const f32x4 wv = *(const f32x4*)(w + (size_t)kk * 6144); a0 += sc[kk] * wv; a1 += sc[64 + kk] * wv; a2 += sc[128 + kk] * wv; }
    if (kc == 0) { const f32x4 bv = *(const f32x4*)(p.b_ada + l * 6144 + n); a0 += bv; a1 += bv; a2 += bv; }
#pragma unroll
    for (int e = 0; e < 4; ++e) { atomicAdd(&MOD[(l * 3 + 0) * 6144 + n + e], a0[e]); atomicAdd(&MOD[(l * 3 + 1) * 6144 + n + e], a1[e]); atomicAdd(&MOD[(l * 3 + 2) * 6144 + n + e], a2[e]); }
    __syncthreads();
}
DEVI void filter_item(const Params& p, int item, float* sm  ) {
    const int l = item / 80, r = item % 80, Lsel = r >= 16, pos0 = (Lsel ? r - 16 : r) * 16, L = Lsel ? 1024 : 256, t = TIDX;
    float* z = sm; float* h1 = sm + 16 * 36; float* h2 = h1 + 16 * 64;
    {
        const int pp = t >> 5, q = t & 31;
        const int pos = pos0 + pp; const float tt = (float)pos / (float)(L - 1);
        const int i = q & 15; const float band = 1e-4f + (float)i * ((15.0f - 1e-4f) / 15.0f); const float ang = (6.283185307179586f / (float)L) * (float)pos * band;
        z[pp * 36 + 1 + q] = (q < 16) ? cosf(ang) : sinf(ang);
        if (q == 0) z[pp * 36] = tt;
    }
    __syncthreads();
#pragma unroll
    for (int e = 0; e < 2; ++e) { const int idx = e * 512 + t, pp = idx >> 6, j = idx & 63; float a = p.hy_b1[l * 64 + j]; float w[33];
        _Pragma("unroll") for (int i = 0; i < 33; ++i) w[i] = p.hy_w1[(l * 33 + i) * 64 + j];
        _Pragma("unroll") for (int i = 0; i < 33; ++i) a += z[pp * 36 + i] * w[i]; h1[pp * 64 + j] = sinf(a); }
    __syncthreads();
#pragma unroll
    for (int e = 0; e < 2; ++e) { const int idx = e * 512 + t, pp = idx >> 6, j = idx & 63; float a = p.hy_b2[l * 64 + j];
        _Pragma("unroll 1") for (int i0 = 0; i0 < 64; i0 += 32) { float w[32];
            _Pragma("unroll") for (int i = 0; i < 32; ++i) w[i] = p.hy_w2[(l * 64 + i0 + i) * 64 + j];
            _Pragma("unroll") for (int i = 0; i < 32; ++i) a += h1[pp * 64 + i0 + i] * w[i]; }
        h2[pp * 64 + j] = sinf(a); }
    __syncthreads();
    float* F = (float*)(p.ws + WS_FILT) + (size_t)l * FILT_PER_LAYER + (Lsel ? (size_t)2 * 256 * 512 : 0);
    const float lo = 3.0701134573253945f, hi = 15.350567286626973f, delta = lo + (float)t * ((hi - lo) / 511.0f);
#pragma unroll
    for (int q = 0; q < 2; ++q) {
        const int n = q * 512 + t; float a[16];
#pragma unroll
        for (int pp = 0; pp < 16; ++pp) a[pp] = 0.f;
#pragma unroll 1
        for (int k0 = 0; k0 < 64; k0 += 16) { float w[16];
#pragma unroll
            for (int k = 0; k < 16; ++k) w[k] = p.hy_w3[(size_t)(l * 64 + k0 + k) * 1024 + n];
#pragma unroll
            for (int k = 0; k < 16; ++k)
#pragma unroll
                for (int pp = 0; pp < 16; ++pp) a[pp] += h2[pp * 64 + k0 + k] * w[k]; }
        float* dst = F + ((size_t)q * 512 + t) * L + pos0;
#pragma unroll
        for (int g = 0; g < 4; ++g) { f32x4 o;
#pragma unroll
            for (int e = 0; e < 4; ++e) { const int pp = g * 4 + e; o[e] = a[pp] * expf(-((float)(pos0 + pp) / (float)(L - 1)) * delta); }
            *(f32x4*)(dst + g * 4) = o; }
    }
    __syncthreads();
}
DEVI void gs_item(const Params& p, int it) {
    const int t = TIDX;
    {
        const int l = it >> 7, Lsel = (it >> 6) & 1, c8 = (it & 63) * 8, L = Lsel ? 1024 : 256;
        const float* F0 = (const float*)(p.ws + WS_FILT) + (size_t)l * FILT_PER_LAYER + (Lsel ? (size_t)2 * 256 * 512 : 0);
        bf16_t* G0 = (bf16_t*)(p.ws + WS_GS) + (size_t)l * GS_PER_LAYER + (Lsel ? GS_L256 : 0);
        const int nchunk = 8 * 2 * L / 8;
        for (int cidx = t; cidx < nchunk; cidx += NT) {
            const int c = cidx / (2 * L / 8), i0 = (cidx % (2 * L / 8)) * 8, ch = c8 + c;
            const float* Ff = F0 + (size_t)ch * L; const float* Fb = Ff + (size_t)512 * L; const float dsk = p.hy_d[l * 512 + ch];
            float v[8];
#pragma unroll
            for (int e = 0; e < 8; ++e) { const int d = L - 1 - (i0 + e); float g = 0.f;
                if (d > 0 && d < L) g = Ff[d]; else if (d < 0 && -d < L) g = Fb[-d]; else if (d == 0) g = Ff[0] + dsk;
                v[e] = g; }
            u32x4 w; w.x = pk2bf(v[0], v[1]); w.y = pk2bf(v[2], v[3]); w.z = pk2bf(v[4], v[5]); w.w = pk2bf(v[6], v[7]);
            *(u32x4*)(G0 + (size_t)ch * 2 * L + i0) = w;
        }
    }
}
DEVI void small_item(const Params& p, int kind, int r, int t) {
    if (kind == 0) {
        const int e = r * 512 + t, c = e & 63, d = (e >> 6) & 63, gate = (e >> 12) & 1, dir = (e >> 13) & 1, n = (e >> 14) & 7, l = e >> 17;
        const float* src = gate ? p.lru_wi : p.lru_wa;
        ((bf16_t*)(p.ws + WS_WGB))[e] = f2bf(src[((size_t)((l * 2 + dir) * 8 + n) * 64 + c) * 64 + d]);
    } else if (kind == 1) {
        const size_t e = ((size_t)r * 512 + t) * 8; const bool isv = e >= CACHE_ELEMS; const size_t o = isv ? e - CACHE_ELEMS : e;
        const float* src = (isv ? p.cache_v : p.cache_k) + o; const f32x4 x0 = *(const f32x4*)src, x1 = *(const f32x4*)(src + 4);
        u32x4 w; w.x = pk2bf(x0[0], x0[1]); w.y = pk2bf(x0[2], x0[3]); w.z = pk2bf(x1[0], x1[1]); w.w = pk2bf(x1[2], x1[3]);
        *(u32x4*)((bf16_t*)(p.ws + (isv ? WS_CVB : WS_CKB)) + o) = w;
    } else {
        const int e = r * 512 + t, tpos = e >> 5, axis = (e >> 4) & 1, f = e & 15;
        const float inv = powf(10000.0f, -(float)f / 16.0f), pv = (float)(axis == 0 ? (tpos >> 6) : (tpos & 63)), ang = pv * inv;
        float* RC = (float*)(p.ws + WS_ROPE);
        RC[e] = cosf(ang); RC[1024 * 32 + e] = sinf(ang);
    }
}
constexpr int I_MOD = 192, I_FILT = 2 * 80, I_ROPE = 64, I_CACHE = (int)(2 * CACHE_ELEMS / (512 * 8)), I_WG = 2 * 8 * 2 * 2 * 64 * 64 / 512, I_TR0 = 1792, I_TR = 3584 + 1024, I_GS = 256;
DEVI void ph_prep(const Params& p, char* lds) {
    float* sm = (float*)lds;
    const int t = TIDX;
    for (int it = blockIdx.x; it < 96 + 80 + I_ROPE; it += gridDim.x) {
        int r = it;
        if (r < 96) { mods_item(p, r, sm);
            asm volatile("s_waitcnt vmcnt(0)" ::: "memory"); __syncthreads();
            if (t == 0) (void)__hip_atomic_fetch_add((unsigned*)(p.ws + WS_CTL) + 2048 + 64 * 7, 1u, __ATOMIC_RELAXED, __HIP_MEMORY_SCOPE_AGENT);
            continue; } r -= 96;
        if (r < 80) { filter_item(p, r, sm); continue; } r -= 80;
        small_item(p, 2, r, t);
    }
    __syncthreads();
    {
        const int c = blockIdx.x; const bool bal = gridDim.x == 256;
        const int first = !bal ? c : (c < 96 ? 6 * c : (c < 176 ? 576 + 7 * (c - 96) : (c < 240 ? 1136 + 8 * (c - 176) : 1648 + 9 * (c - 240))));
        const int cnt = !bal ? (I_TR0 - c + (int)gridDim.x - 1) / (int)gridDim.x : (c < 96 ? 6 : (c < 176 ? 7 : (c < 240 ? 8 : 9))), step = bal ? 1 : (int)gridDim.x;
        f32x4 cur[4], nxt[4]; TrItem ci, ni;
        if (cnt > 0) { ci = tr_decode(p, first); tr_load(ci, t, cur); }
        for (int k = 0; k < cnt; ++k) {
            const bool more = k + 1 < cnt;
            if (more) { ni = tr_decode(p, first + (k + 1) * step); tr_load(ni, t, nxt); }
            tr_store(ci, t, cur, sm);
            if (more) { ci = ni;
#pragma unroll
                for (int i = 0; i < 4; ++i) cur[i] = nxt[i]; }
        }
    }
}
DEVI void tr_batch(const Params& p, int first, int count, int t, float* sm) {
    f32x4 cur[4], nxt[4]; TrItem ci = tr_decode(p, first), ni = ci;
    tr_load(ci, t, cur);
#pragma unroll 1
    for (int k = 0; k < count; ++k) {
        const bool more = k + 1 < count;
        if (more) { ni = tr_decode(p, first + k + 1); tr_load(ni, t, nxt); }
        tr_store(ci, t, cur, sm);
        if (more) { ci = ni;
#pragma unroll
            for (int i = 0; i < 4; ++i) cur[i] = nxt[i]; }
    }
}
DEVI void ph_filler(const Params& p, char* lds, int stage) {
    float* sm = (float*)lds;
    const int t = TIDX;
    const int NF = stage == 0 ? 96 + 80 + 128 + 128 + I_CACHE / 8 + I_WG / 8 : (stage == 1 ? 448 : 256);
    unsigned* qctr = (unsigned*)(p.ws + WS_CTL) + 2048 + 64 * stage;
    volatile int* slot = (volatile int*)(lds + LDS_QSLOT);
    for (;;) {
        __syncthreads();
        if (t == 0) *slot = (int)__hip_atomic_fetch_add(qctr, 1u, __ATOMIC_RELAXED, __HIP_MEMORY_SCOPE_AGENT);
        __syncthreads();
        int r = __builtin_amdgcn_readfirstlane(*slot);
        if (r >= NF) break;
        if (stage == 0) {
            if (r < 96) { mods_item(p, 96 + r, sm); continue; } r -= 96;
            if (r < 80) { filter_item(p, 80 + r, sm); continue; } r -= 80;
            if (r < 128) { gs_item(p, r); continue; } r -= 128;
            if (r < 128) { tr_batch(p, 3584 + 4 * r, 4, t, sm); continue; } r -= 128;
            if (r < I_CACHE / 8) { for (int k = 0; k < 8; ++k) small_item(p, 1, r * 8 + k, t); continue; } r -= I_CACHE / 8;
            for (int k = 0; k < 8; ++k) small_item(p, 0, r * 8 + k, t);
        } else if (stage == 1) {
            tr_batch(p, 1792 + 4 * r, 4, t, sm);
        } else {
            if (r < 128) { gs_item(p, 128 + r); continue; } r -= 128;
            tr_batch(p, 3584 + 512 + 4 * r, 4, t, sm);
        }
    }
}

DEVI void ph_mods_wait(const Params& p) {
    __syncthreads();
    if (TIDX == 0) { unsigned* done = (unsigned*)(p.ws + WS_CTL) + 2048 + 64 * 7; unsigned sp = 0u;
        asm volatile("buffer_inv sc1" ::: "memory");
        while (__hip_atomic_load(done, __ATOMIC_RELAXED, __HIP_MEMORY_SCOPE_AGENT) < 96u && ++sp < (1u << 22)) __builtin_amdgcn_s_sleep(2);
        asm volatile("s_waitcnt vmcnt(0)" ::: "memory"); }
    __syncthreads();
}
DEVI void ph_norm(const Params& p, int l) {
    const int wid = TIDX >> 6, lane = TIDX & 63, gw = blockIdx.x * (NT / 64) + wid, NGW = gridDim.x * (NT / 64);
    const float* X = p.out;
    const float* MOD = (const float*)(p.ws + WS_MOD);
    bf16_t* H = (bf16_t*)(p.ws + WS_H);
    for (int row = gw; row < MT; row += NGW) {
        const float* xr = (l == 0) ? (row < MC ? p.x_prompt + (size_t)row * D : p.x_sample + (size_t)(row - MC) * D) : X + (size_t)row * D;
        const float* md = MOD + (size_t)(l * 3 + cond_of_row(row)) * 6144;
        f32x4 v[8]; float ss = 0.f;
#pragma unroll
        for (int j = 0; j < 8; ++j) { v[j] = *(const f32x4*)(xr + j * 256 + lane * 4); ss += v[j][0] * v[j][0] + v[j][1] * v[j][1] + v[j][2] * v[j][2] + v[j][3] * v[j][3]; }
        const float rs = rsqrtf(wave_sum(ss) * (1.0f / D) + 1e-6f);
#pragma unroll
        for (int hf = 0; hf < 2; ++hf) {
            f32x4 g[4], sh[4], scl[4];
#pragma unroll
            for (int jj = 0; jj < 4; ++jj) { const int c0 = (hf * 4 + jj) * 256 + lane * 4; g[jj] = *(const f32x4*)(p.norm_g + l * D + c0); sh[jj] = *(const f32x4*)(md + c0); scl[jj] = *(const f32x4*)(md + 2048 + c0); }
#pragma unroll
            for (int jj = 0; jj < 4; ++jj) {
                const int j = hf * 4 + jj, c0 = j * 256 + lane * 4;
                float o[4];
#pragma unroll
                for (int e = 0; e < 4; ++e) o[e] = v[j][e] * rs * g[jj][e] * (1.0f + scl[jj][e]) + sh[jj][e];
                *(uint2*)(H + (size_t)row * D + c0) = make_uint2(pk2bf(o[0], o[1]), pk2bf(o[2], o[3]));
            }
        }
    }
}

constexpr int BM = 256, BK = 64, HALF = 128, HTB = HALF * BK * 2, GEMM_LDS = 8 * HTB;
DEVI int lds_byte(int r, int c) { const int st = (r >> 4) * 2 + (c >> 5), rr = r & 15, cc = c & 31, ob = rr * 64 + cc * 2; return st * 1024 + (ob ^ (((ob >> 9) & 1) << 5)); }
DEVI void stage_rc(int b, int& R, int& C) { const int st = b / 1024, sb = b % 1024, swz = sb ^ (((sb >> 9) & 1) << 5); R = (st >> 1) * 16 + swz / 64; C = (st & 1) * 32 + (swz % 64) / 2; }
DEVI int perm32(int rho) { const int n = rho >> 4, i = rho & 15; return 8 * (i >> 2) + 4 * n + (i & 3); }
struct Unit { int pm, pn; };
struct StaticOrder {
    int nM, nN, nwg, G, c;
    DEVI void init(int M, int N, int G_, int c_) { nM = M / BM; nN = N / BM; nwg = nM * nN; G = G_; c = c_; }
    DEVI bool next(int i, Unit& u) const {
        const long L = (long)i * G + c; if (L >= nwg) return false;
        int wgid = (int)L; { const int q = nwg / 8, r = nwg % 8, xcd = wgid % 8, off = wgid / 8; wgid = (xcd < r ? xcd * (q + 1) : r * (q + 1) + (xcd - r) * q) + off; }
        const int nig = 8 * nN, gid = wgid / nig, fm = gid * 8, gsz = (nM - fm) < 8 ? (nM - fm) : 8;
        u.pm = fm + ((wgid % nig) % gsz); u.pn = (wgid % nig) / gsz; return true;
    }
};
template <class Epi>
DEVI void gemm_phase(LAS unsigned char* lds, const bf16_t* gA, const bf16_t* gBt, const int K, const StaticOrder& S, const Epi& E) {
    const int tid = TIDX, wid = __builtin_amdgcn_readfirstlane(tid >> 6), lane = tid & 63, wr = wid >> 2, wc = wid & 3, fr = lane & 15, fq = lane >> 4;
    const int nt = K / BK;
    unsigned voffA[2], voffB[2];
#pragma unroll
    for (int i = 0; i < 2; ++i) { int R, C; stage_rc(tid * 16 + i * 8192, R, C); const int Rb = Epi::PERM ? ((R & ~31) + perm32(R & 31)) : R;
        voffA[i] = (unsigned)(R * K + C) * 2u; voffB[i] = (unsigned)(Rb * K + C) * 2u; }
    const size_t kstep = (size_t)(BK * 2), hstep = (size_t)HALF * K * 2, tstep = 2 * hstep;
    const unsigned ldsw = (unsigned)wid * 1024u;
    const int aoff = lds_byte(wr * 64 + fr, fq * 8), boff = lds_byte(wc * 32 + fr, fq * 8);
#define PG8_SA(b, h) (((b) * 2 + (h)) * HTB)
#define PG8_SB(b, h) ((4 + (b) * 2 + (h)) * HTB)
#define PG8_STAGE(bufoff, gbase, voff) do { _Pragma("unroll") for (int _i = 0; _i < 2; ++_i) \
        __builtin_amdgcn_global_load_lds((const unsigned*)((const char*)(gbase) + (voff)[_i]), (LAS unsigned*)(lds + (bufoff) + ldsw + _i * 8192), 16, 0, 0); } while (0)
#define PG8_LDA(dst, b, h) do { _Pragma("unroll") for (int m = 0; m < 4; ++m) _Pragma("unroll") for (int k = 0; k < 2; ++k) dst[m][k] = *(const LAS bf16x8*)(lds + PG8_SA(b, h) + aoff + m * 2048 + k * 1024); } while (0)
#define PG8_LDB(dst, b, h) do { _Pragma("unroll") for (int n = 0; n < 2; ++n) _Pragma("unroll") for (int k = 0; k < 2; ++k) dst[n][k] = *(const LAS bf16x8*)(lds + PG8_SB(b, h) + boff + n * 2048 + k * 1024); } while (0)
#define PG8_MMA(ai, bj, At, Bt) do { __builtin_amdgcn_s_setprio(1); _Pragma("unroll") for (int m = 0; m < 4; ++m) _Pragma("unroll") for (int n = 0; n < 2; ++n) _Pragma("unroll") for (int k = 0; k < 2; ++k) \
        acc[ai][bj][m][n] = __builtin_amdgcn_mfma_f32_16x16x32_bf16(Bt[n][k], At[m][k], acc[ai][bj][m][n], 0, 0, 0); __builtin_amdgcn_s_setprio(0); } while (0)
#define PG8_WAIT_V(n) asm volatile("s_waitcnt vmcnt(" #n ")" ::: "memory")
#define PG8_WAIT_L(n) asm volatile("s_waitcnt lgkmcnt(" #n ")" ::: "memory")
#define PG8_BAR __builtin_amdgcn_s_barrier()
#define PG8_SCHED __builtin_amdgcn_sched_barrier(0)
    Unit cur, nxt; int ui = 0;
    if (!S.next(0, cur)) return;
    f32x4 acc[2][2][4][2];
#pragma unroll
    for (int a = 0; a < 2; ++a)
#pragma unroll
        for (int b = 0; b < 2; ++b)
#pragma unroll
            for (int m = 0; m < 4; ++m)
#pragma unroll
                for (int n = 0; n < 2; ++n) acc[a][b][m][n] = (f32x4){0.f, 0.f, 0.f, 0.f};
    bf16x8 At[4][2], B0[2][2], B1[2][2];
    const char* cA = (const char*)gA + (size_t)cur.pm * tstep; const char* cB = (const char*)gBt + (size_t)cur.pn * tstep;
    PG8_STAGE(PG8_SB(0, 0), cB, voffB); PG8_STAGE(PG8_SB(0, 1), cB + hstep, voffB); PG8_STAGE(PG8_SA(0, 0), cA, voffA); PG8_STAGE(PG8_SA(0, 1), cA + hstep, voffA);
    if (wr == 1) PG8_BAR;
    PG8_WAIT_V(2); PG8_BAR;
    PG8_STAGE(PG8_SB(1, 0), cB + kstep, voffB); PG8_STAGE(PG8_SA(1, 0), cA + kstep, voffA); PG8_STAGE(PG8_SB(1, 1), cB + hstep + kstep, voffB);
    PG8_WAIT_V(6); PG8_BAR;
    for (;;) {
        const bool has_next = S.next(ui + 1, nxt);
        const char* nA = has_next ? (const char*)gA + (size_t)nxt.pm * tstep : cA; const char* nB = has_next ? (const char*)gBt + (size_t)nxt.pn * tstep : cB;
        for (int t = 0; t < nt; t += 2) {
            const bool last = (t == nt - 2);
            const char* a1 = cA + (size_t)(t + 1) * kstep;
            const char* a2 = last ? nA : cA + (size_t)(t + 2) * kstep; const char* b2 = last ? nB : cB + (size_t)(t + 2) * kstep;
            const char* a3 = a2 + kstep; const char* b3 = b2 + kstep;
            PG8_LDB(B0, 0, 0); PG8_LDB(B1, 0, 1); PG8_SCHED; PG8_LDA(At, 0, 0); PG8_STAGE(PG8_SA(1, 1), a1 + hstep, voffA);
            PG8_WAIT_V(8); PG8_WAIT_L(0); PG8_BAR; PG8_MMA(0, 0, At, B0); PG8_MMA(0, 1, At, B1); PG8_BAR; PG8_SCHED;
            PG8_LDA(At, 0, 1); PG8_STAGE(PG8_SB(0, 0), b2, voffB); PG8_STAGE(PG8_SB(0, 1), b2 + hstep, voffB); PG8_STAGE(PG8_SA(0, 0), a2, voffA);
            PG8_WAIT_V(8); PG8_WAIT_L(0); PG8_BAR; PG8_MMA(1, 0, At, B0); PG8_MMA(1, 1, At, B1); PG8_BAR; PG8_SCHED;
            PG8_LDB(B0, 1, 0); PG8_LDB(B1, 1, 1); PG8_SCHED; PG8_LDA(At, 1, 0); PG8_STAGE(PG8_SA(0, 1), a2 + hstep, voffA);
            PG8_WAIT_V(8); PG8_WAIT_L(0); PG8_BAR; PG8_MMA(0, 0, At, B0); PG8_MMA(0, 1, At, B1); PG8_BAR; PG8_SCHED;
            PG8_LDA(At, 1, 1); PG8_STAGE(PG8_SB(1, 0), b3, voffB); PG8_STAGE(PG8_SB(1, 1), b3 + hstep, voffB); PG8_STAGE(PG8_SA(1, 0), a3, voffA);
            PG8_WAIT_V(8); PG8_WAIT_L(0); PG8_BAR; PG8_MMA(1, 0, At, B0); PG8_MMA(1, 1, At, B1); PG8_BAR; PG8_SCHED;
        }
        if (wr == 0) PG8_BAR;
        E(acc, cur, wr, wc, fr, fq);
        if (!has_next) break;
#pragma unroll
        for (int a = 0; a < 2; ++a)
#pragma unroll
            for (int b = 0; b < 2; ++b)
#pragma unroll
                for (int m = 0; m < 4; ++m)
#pragma unroll
                    for (int n = 0; n < 2; ++n) acc[a][b][m][n] = (f32x4){0.f, 0.f, 0.f, 0.f};
        cur = nxt; cA = nA; cB = nB; ++ui;
        if (wr == 1) PG8_BAR;
    }
    PG8_WAIT_V(0);
    PG8_BAR;
}
template <class Epi>
DEVI void gemm_quarter(LAS unsigned char* lds, const bf16_t* gA, const bf16_t* gBt, const int K, const Epi& E) {
    const int tid = TIDX, wid = __builtin_amdgcn_readfirstlane(tid >> 6), lane = tid & 63, wr = wid >> 2, wc = wid & 3, fr = lane & 15, fq = lane >> 4;
    const int nt = K / BK;
    unsigned voff[2], voffB[2];
#pragma unroll
    for (int i = 0; i < 2; ++i) { int R, C; stage_rc(tid * 16 + i * 8192, R, C); voff[i] = (unsigned)(R * K + C) * 2u; voffB[i] = (unsigned)(((R & ~31) + perm32(R & 31)) * K + C) * 2u; }
    const size_t kstep = (size_t)(BK * 2);
    const unsigned ldsw = (unsigned)wid * 1024u;
    const int aoff = lds_byte(wr * 64 + fr, fq * 8), boff = lds_byte(wc * 32 + fr, fq * 8);
    f32x4 acc[1][1][4][2];
#pragma unroll
    for (int m = 0; m < 4; ++m)
#pragma unroll
        for (int n = 0; n < 2; ++n) acc[0][0][m][n] = (f32x4){0.f, 0.f, 0.f, 0.f};
    bf16x8 At[4][2], B0[2][2];
    const char* cA = (const char*)gA; const char* cB = (const char*)gBt;
#define QSTEP(r, tt) do { const int tn_ = ((tt) + 3 < nt) ? (tt) + 3 : nt - 1;     \
        PG8_WAIT_V(8); PG8_BAR; \
        PG8_STAGE(PG8_SB((((r) + 3) & 3) >> 1, ((r) + 3) & 1), cB + (size_t)tn_ * kstep, voffB); PG8_STAGE(PG8_SA((((r) + 3) & 3) >> 1, ((r) + 3) & 1), cA + (size_t)tn_ * kstep, voff); \
        PG8_LDB(B0, (r) >> 1, (r) & 1); PG8_LDA(At, (r) >> 1, (r) & 1); PG8_WAIT_L(0); PG8_MMA(0, 0, At, B0); } while (0)
    PG8_STAGE(PG8_SB(0, 0), cB, voffB); PG8_STAGE(PG8_SA(0, 0), cA, voff);
    PG8_STAGE(PG8_SB(0, 1), cB + kstep, voffB); PG8_STAGE(PG8_SA(0, 1), cA + kstep, voff);
    PG8_STAGE(PG8_SB(1, 0), cB + 2 * kstep, voffB); PG8_STAGE(PG8_SA(1, 0), cA + 2 * kstep, voff);
    for (int t = 0; t < nt; t += 4) { QSTEP(0, t); QSTEP(1, t + 1); QSTEP(2, t + 2); QSTEP(3, t + 3); }
#undef QSTEP
    E(acc[0][0], wr, wc, fr, fq);
    PG8_WAIT_V(0);
    PG8_BAR;
}
#undef PG8_SA
#undef PG8_SB
#undef PG8_STAGE
#undef PG8_LDA
#undef PG8_LDB
#undef PG8_MMA
struct EpiIn {
    static constexpr bool PERM = true;
    int l;
    DEVI void operator()(const f32x4 (&acc)[2][2][4][2], const Unit& u, int wr, int wc, int fr, int fq) const {
        KPARAMS(pe); bf16_t* P = (bf16_t*)(pe.ws + WS_P); float* out = pe.out; const float* RC = (const float*)(pe.ws + WS_ROPE);
        const int row0 = u.pm * BM + wr * 64 + fr, col0 = u.pn * BM + wc * 32 + 8 * fq;
        const bool cache = (row0 < MC) && (col0 >= CK) && (col0 < CAG);
        const bool hyt = col0 >= CHV; bf16_t* PHb = (bf16_t*)(pe.ws + WS_PH);
        const bool rope = (row0 >= MC) && (col0 < CV);
        const float* rcb = RC + (wc & 1) * 16 + 8 * (fq & 1); const float sgn = fq < 2 ? -1.f : 1.f;
        float rsv[2][4]; f32x4 sw[2][2];
        if (l != 0) {
            const float* SS = (const float*)(pe.ws + WS_SS) + row0; const float* swp = (const float*)(pe.ws + WS_SW) + cond_of_row(u.pm * BM) * IN_W + col0;
#pragma unroll
            for (int ai = 0; ai < 2; ++ai)
#pragma unroll
                for (int m = 0; m < 4; ++m) rsv[ai][m] = rsqrtf(SS[ai * HALF + m * 16] * (1.0f / D) + 1e-6f);
#pragma unroll
            for (int bj = 0; bj < 2; ++bj) { sw[bj][0] = *(const f32x4*)(swp + bj * HALF); sw[bj][1] = *(const f32x4*)(swp + bj * HALF + 4); }
        }
#pragma unroll
        for (int ai = 0; ai < 2; ++ai)
#pragma unroll
            for (int m = 0; m < 4; ++m) {
                const int row = row0 + ai * HALF + m * 16;
                bf16_t* rowp = hyt ? PHb + ((size_t)((col0 - CHV) >> 3) * MT + row) * 8 : P + (size_t)row * IN_W + col0;
#pragma unroll
                for (int bj = 0; bj < 2; ++bj) {
                    f32x4 v0 = acc[ai][bj][m][0], v1 = acc[ai][bj][m][1];
                    if (l != 0) { v0 = v0 * rsv[ai][m] + sw[bj][0]; v1 = v1 * rsv[ai][m] + sw[bj][1]; }
                    if (rope) {
                        const float* rc = rcb + ((row - MC) & (DSEQ - 1)) * 32;
                        const f32x4 c0 = *(const f32x4*)rc, c1 = *(const f32x4*)(rc + 4), s0 = *(const f32x4*)(rc + 1024 * 32), s1 = *(const f32x4*)(rc + 1024 * 32 + 4);
#pragma unroll
                        for (int e = 0; e < 4; ++e) { const auto q0 = __builtin_amdgcn_permlane32_swap(__float_as_uint(v0[e]), __float_as_uint(v0[e]), false, false), q1 = __builtin_amdgcn_permlane32_swap(__float_as_uint(v1[e]), __float_as_uint(v1[e]), false, false);
                            const float p0 = __uint_as_float(fq < 2 ? q0[1] : q0[0]), p1 = __uint_as_float(fq < 2 ? q1[1] : q1[0]); v0[e] = v0[e] * c0[e] + sgn * p0 * s0[e]; v1[e] = v1[e] * c1[e] + sgn * p1 * s1[e]; }
                    }
                    u32x4 w; w.x = pk2bf(v0[0], v0[1]); w.y = pk2bf(v0[2], v0[3]); w.z = pk2bf(v1[0], v1[1]); w.w = pk2bf(v1[2], v1[3]);
                    *(u32x4*)(rowp + (hyt ? (size_t)(bj * HALF / 8) * MT * 8 : (size_t)(bj * HALF))) = w;
                    if (cache) {
                        const int col = col0 + bj * HALF, which = col >= CV, cc = col - CK - which * 1024, b = row >> 8, t = row & 255;
                        float* o = out + (which ? OUT_V : OUT_K) + ((size_t)(b * 2 + l) * 256 + t) * 1024 + cc;
                        *(f32x4*)o = v0; *(f32x4*)(o + 4) = v1;
                    }
                }
            }
    }
};
DEVI void out_cols(int l, f32x4 g0, f32x4 g1, f32x4 k0, f32x4 k1, const float* xin_f, const bf16_t* xin_b, float* Xf, bf16_t* Xb, bf16_t* Hp, const f32x4* const (&a0)[4], const f32x4* const (&a1)[4], float (&ss)[4]) {
    if (l == 0) {
        f32x4 xa[4], xc[4];
#pragma unroll
        for (int i = 0; i < 4; ++i) { xa[i] = *(const f32x4*)(xin_f + (size_t)(i * 16) * D); xc[i] = *(const f32x4*)(xin_f + (size_t)(i * 16) * D + 4); }
#pragma unroll
        for (int i = 0; i < 4; ++i) {
            const f32x4 x0 = xa[i] + g0 * *a0[i], x1 = xc[i] + g1 * *a1[i], h0 = x0 * k0, h1 = x1 * k1;
            ss[i] += x0[0] * x0[0] + x0[1] * x0[1] + x0[2] * x0[2] + x0[3] * x0[3] + x1[0] * x1[0] + x1[1] * x1[1] + x1[2] * x1[2] + x1[3] * x1[3];
            u32x4 w; w.x = pk2bf(x0[0], x0[1]); w.y = pk2bf(x0[2], x0[3]); w.z = pk2bf(x1[0], x1[1]); w.w = pk2bf(x1[2], x1[3]);
            u32x4 v; v.x = pk2bf(h0[0], h0[1]); v.y = pk2bf(h0[2], h0[3]); v.z = pk2bf(h1[0], h1[1]); v.w = pk2bf(h1[2], h1[3]);
            *(u32x4*)(Xb + (size_t)(i * 16) * D) = w; *(u32x4*)(Hp + (size_t)(i * 16) * D) = v;
        }
    } else {
        u32x4 xr[4];
#pragma unroll
        for (int i = 0; i < 4; ++i) xr[i] = *(const u32x4*)(xin_b + (size_t)(i * 16) * D);
#pragma unroll
        for (int i = 0; i < 4; ++i) {
            const f32x4 x0 = {__uint_as_float(xr[i].x << 16), __uint_as_float(xr[i].x & 0xffff0000u), __uint_as_float(xr[i].y << 16), __uint_as_float(xr[i].y & 0xffff0000u)};
            const f32x4 x1 = {__uint_as_float(xr[i].z << 16), __uint_as_float(xr[i].z & 0xffff0000u), __uint_as_float(xr[i].w << 16), __uint_as_float(xr[i].w & 0xffff0000u)};
            const f32x4 y0 = x0 + g0 * *a0[i], y1 = x1 + g1 * *a1[i];
            u32x4 w; w.x = pk2bf(y0[0], y0[1]); w.y = pk2bf(y0[2], y0[3]); w.z = pk2bf(y1[0], y1[1]); w.w = pk2bf(y1[2], y1[3]);
            *(u32x4*)(Hp + (size_t)(i * 16) * D) = w;
        }
    }
}
DEVI void out_ss(float v, float* dst, int fq) {
    v += swz_xor<16>(v);
    const auto rr = __builtin_amdgcn_permlane32_swap(__float_as_uint(v), __float_as_uint(v), false, false);
    if (fq == 0) atomicAdd(dst, __uint_as_float(rr[0]) + __uint_as_float(rr[1]));
}
struct EpiOut {
    static constexpr bool PERM = true;
    int l;
    DEVI void operator()(const f32x4 (&acc)[2][2][4][2], const Unit& u, int wr, int wc, int fr, int fq) const {
        KPARAMS(pe); const float* MOD = (const float*)(pe.ws + WS_MOD);
        const int rloc = wr * 64 + fr, row0 = u.pm * BM + rloc, col0 = u.pn * BM + wc * 32 + 8 * fq, cond = cond_of_row(u.pm * BM);
        const float* gate = MOD + (size_t)(l * 3 + cond) * 6144 + 4096 + col0;
        const float* sc1 = MOD + (size_t)(3 + cond) * 6144 + 2048 + col0; const float* gk1 = pe.norm_g + D + col0;
        const float* xin_f = (row0 < MC ? pe.x_prompt : pe.x_sample - (size_t)MC * D) + (size_t)row0 * D + col0;
        bf16_t* Xb = xb_rows(pe.ws, u.pm * BM) + (size_t)rloc * D + col0; bf16_t* Hp = (bf16_t*)(pe.ws + WS_H) + (size_t)row0 * D + col0; float* Xf = pe.out + (size_t)row0 * D + col0;
        f32x4 g[2][2], k[2][2];
#pragma unroll
        for (int bj = 0; bj < 2; ++bj)
#pragma unroll
            for (int n = 0; n < 2; ++n) { g[bj][n] = *(const f32x4*)(gate + bj * HALF + 4 * n); k[bj][n] = g[bj][n];
                if (l == 0) k[bj][n] = *(const f32x4*)(gk1 + bj * HALF + 4 * n) * (1.0f + *(const f32x4*)(sc1 + bj * HALF + 4 * n)); }
        float ss[2][4] = {{0.f, 0.f, 0.f, 0.f}, {0.f, 0.f, 0.f, 0.f}};
#pragma unroll
        for (int bj = 0; bj < 2; ++bj)
#pragma unroll
            for (int ai = 0; ai < 2; ++ai) {
                const size_t o = (size_t)(ai * HALF) * D + bj * HALF;
                const f32x4* const a0[4] = {&acc[ai][bj][0][0], &acc[ai][bj][1][0], &acc[ai][bj][2][0], &acc[ai][bj][3][0]};
                const f32x4* const a1[4] = {&acc[ai][bj][0][1], &acc[ai][bj][1][1], &acc[ai][bj][2][1], &acc[ai][bj][3][1]};
                out_cols(l, g[bj][0], g[bj][1], k[bj][0], k[bj][1], xin_f + o, Xb + o, Xf + o, Xb + o, Hp + o, a0, a1, ss[ai]);
            }
        if (l == 0) {
            float* SS = (float*)(pe.ws + WS_SS) + row0;
#pragma unroll
            for (int ai = 0; ai < 2; ++ai)
#pragma unroll
                for (int m = 0; m < 4; ++m) out_ss(ss[ai][m], SS + ai * HALF + m * 16, fq);
        }
    }
};
struct EpiOutQ {
    int l, rbase, cbase;
    DEVI void operator()(const f32x4 (&acc)[4][2], int wr, int wc, int fr, int fq) const {
        KPARAMS(pe); const float* MOD = (const float*)(pe.ws + WS_MOD);
        const int row0 = rbase + wr * 64 + fr, col0 = cbase + wc * 32 + 8 * fq, cond = cond_of_row(rbase);
        const float* gate = MOD + (size_t)(l * 3 + cond) * 6144 + 4096 + col0;
        const float* sc1 = MOD + (size_t)(3 + cond) * 6144 + 2048 + col0; const float* gk1 = pe.norm_g + D + col0;
        const float* xin_f = pe.x_sample + (size_t)(row0 - MC) * D + col0;
        bf16_t* Xb = xb_rows(pe.ws, rbase) + (size_t)(row0 - rbase) * D + col0; bf16_t* Hp = (bf16_t*)(pe.ws + WS_H) + (size_t)row0 * D + col0; float* Xf = pe.out + (size_t)row0 * D + col0;
        f32x4 g[2], k[2];
#pragma unroll
        for (int n = 0; n < 2; ++n) { g[n] = *(const f32x4*)(gate + 4 * n); k[n] = g[n]; if (l == 0) k[n] = *(const f32x4*)(gk1 + 4 * n) * (1.0f + *(const f32x4*)(sc1 + 4 * n)); }
        float ss[4] = {0.f, 0.f, 0.f, 0.f};
        const f32x4* const a0[4] = {&acc[0][0], &acc[1][0], &acc[2][0], &acc[3][0]};
        const f32x4* const a1[4] = {&acc[0][1], &acc[1][1], &acc[2][1], &acc[3][1]};
        out_cols(l, g[0], g[1], k[0], k[1], xin_f, Xb, Xf, Xb, Hp, a0, a1, ss);
        if (l == 0) {
            float* SS = (float*)(pe.ws + WS_SS) + row0;
#pragma unroll
            for (int i = 0; i < 4; ++i) out_ss(ss[i], SS + i * 16, fq);
        }
    }
};
DEVI void ph_gemm_in(const Params& p, int l, char* lds) {
    EpiIn e{l};
    StaticOrder S; S.init(MT, IN_W, gridDim.x, blockIdx.x);
    gemm_phase((LAS unsigned char*)lds, (const bf16_t*)(p.ws + WS_H), (const bf16_t*)(p.ws + WS_WINT) + (size_t)l * IN_W * D, D, S, e);
}
DEVI void ph_gemm_out(const Params& p, int l, char* lds) {
    EpiOut e{l};
    StaticOrder S; S.init(MC, D, gridDim.x, blockIdx.x);
    gemm_phase((LAS unsigned char*)lds, (const bf16_t*)(p.ws + WS_MIX), (const bf16_t*)(p.ws + WS_WOUTT) + (size_t)l * D * D, D, S, e);
    for (int q = blockIdx.x; q < (MS / HALF) * (D / HALF); q += gridDim.x) {
        const int x = q & 7, s = (q >> 3) & 31, qm = 4 * (x >> 1) + (s & 3), qn = 8 * (x & 1) + (s >> 2);
        EpiOutQ eq{l, MC + qm * HALF, qn * HALF};
        gemm_quarter((LAS unsigned char*)lds, (const bf16_t*)(p.ws + WS_MIX) + (size_t)(MC + qm * HALF) * D, (const bf16_t*)(p.ws + WS_WOUTT) + (size_t)l * D * D + (size_t)(qn * HALF) * D, D, eq);
    }
}

namespace att {
using s16x4 = __attribute__((ext_vector_type(4))) short;
using f32x16 = __attribute__((ext_vector_type(16))) float;
constexpr int KVBLK = 64, SHM_V = 64 * 128 * 2, SHM_K = 64 * 128 * 2;
constexpr float SCALE = 0.125f, THR = 8.f;
#define KSWZ(row, colB) ((row) * 256 + ((colB) ^ (((row) & 7) << 4)))
#define SBAR() __builtin_amdgcn_sched_barrier(0)
DEVI int crow(int r, int hi) { return (r & 3) + 8 * (r >> 2) + 4 * hi; }
DEVI unsigned cvtpk(float lo, float hi) { unsigned r; asm volatile("v_cvt_pk_bf16_f32 %0, %1, %2" : "=v"(r) : "v"(lo), "v"(hi)); return r; }
DEVI void partialSM(f32x16& p0, f32x16& p1, float& m_reg, float& mn, float& alpha) {
    constexpr float C = SCALE * 1.4426950408889634f;
    float pmax = p0[0];
#pragma unroll
    for (int r = 1; r < 16; ++r) pmax = fmaxf(pmax, p0[r]);
#pragma unroll
    for (int r = 0; r < 16; ++r) pmax = fmaxf(pmax, p1[r]);
    { auto rr = __builtin_amdgcn_permlane32_swap(__float_as_uint(pmax), __float_as_uint(pmax), false, false); pmax = fmaxf(__uint_as_float(rr[0]), __uint_as_float(rr[1])); }
    if (__builtin_expect(__all(pmax - m_reg <= THR / SCALE), 1)) { mn = m_reg; alpha = 1.f; }
    else { mn = fmaxf(m_reg, pmax); alpha = __builtin_amdgcn_exp2f((m_reg - mn) * C); m_reg = mn; }
    const float mnC = -mn * C;
#pragma unroll
    for (int r = 0; r < 16; ++r) p0[r] = fmaf(p0[r], C, mnC);
#pragma unroll
    for (int r = 0; r < 16; ++r) p1[r] = fmaf(p1[r], C, mnC);
#pragma unroll
    for (int r = 0; r < 16; ++r) p0[r] = __builtin_amdgcn_exp2f(p0[r]);
}
DEVI void finishSM(f32x16& p0, f32x16& p1, float alpha, float& l_reg, bf16x8& pa0, bf16x8& pa1, bf16x8& pa2, bf16x8& pa3) {
#pragma unroll
    for (int r = 0; r < 16; ++r) p1[r] = __builtin_amdgcn_exp2f(p1[r]);
    float ps = 0;
#pragma unroll
    for (int r = 0; r < 16; ++r) ps += p0[r];
#pragma unroll
    for (int r = 0; r < 16; ++r) ps += p1[r];
    { auto rr = __builtin_amdgcn_permlane32_swap(__float_as_uint(ps), __float_as_uint(ps), false, false); ps = __uint_as_float(rr[0]) + __uint_as_float(rr[1]); }
    l_reg = l_reg * alpha + ps;
#define PK4(P, BASE, OUT) do { unsigned a0 = cvtpk(P[BASE + 0], P[BASE + 1]), a1 = cvtpk(P[BASE + 2], P[BASE + 3]);   \
    unsigned b0 = cvtpk(P[BASE + 4], P[BASE + 5]), b1 = cvtpk(P[BASE + 6], P[BASE + 7]);                              \
    auto r0 = __builtin_amdgcn_permlane32_swap(a0, b0, false, false); auto r1 = __builtin_amdgcn_permlane32_swap(a1, b1, false, false); \
    u32x4 w = {r0[0], r1[0], r0[1], r1[1]}; OUT = *reinterpret_cast<bf16x8*>(&w); } while (0)
    PK4(p0, 0, pa0); PK4(p0, 8, pa1); PK4(p1, 0, pa2); PK4(p1, 8, pa3);
#undef PK4
}
DEVI void qkt(f32x16& p0, f32x16& p1, const char* Ks, const bf16x8* qr, int r32, int hi, int c) {
    p0 = f32x16{}; p1 = f32x16{};
#pragma unroll
    for (int d0 = 0; d0 < 4; ++d0) { const int cb = ((c * 4 + d0) * 16 + hi * 8) * 2;
        const bf16x8 b0 = *reinterpret_cast<const bf16x8*>(Ks + KSWZ(r32, cb));
        const bf16x8 b1 = *reinterpret_cast<const bf16x8*>(Ks + KSWZ(32 + r32, cb));
        p0 = __builtin_amdgcn_mfma_f32_32x32x16_bf16(b0, qr[d0], p0, 0, 0, 0);
        p1 = __builtin_amdgcn_mfma_f32_32x32x16_bf16(b1, qr[d0], p1, 0, 0, 0); }
}
DEVI int v_st(int k, int c) { const int kk = (k & ~0xC) | ((k & 4) << 1) | ((k & 8) >> 1); return ((kk >> 3) * 4 + (c >> 5)) * 512 + ((kk & 7) * 32 + (c & 31)) * 2; }
DEVI int v_rd_base(int lane) { return ((lane & 3) << 3) | (((lane >> 2) & 3) << 6) | (((lane >> 4) & 1) << 5) | (((lane >> 5) & 1) << 8); }
constexpr int v_rd_off(int d0, int ks, int half) { return d0 * 512 + ks * 4096 + half * 2048; }
template <int OFF> DEVI s16x4 tr_read(int vb) { s16x4 r; asm volatile("ds_read_b64_tr_b16 %0, %1 offset:%2" : "=&v"(r) : "v"(vb), "i"(OFF) : "memory"); return r; }
template <int D0> DEVI void pv_one(f32x16& od, int vb, bf16x8 pa0, bf16x8 pa1, bf16x8 pa2, bf16x8 pa3) {
    const s16x4 l0 = tr_read<v_rd_off(D0, 0, 0)>(vb), h0 = tr_read<v_rd_off(D0, 0, 1)>(vb), l1 = tr_read<v_rd_off(D0, 1, 0)>(vb), h1 = tr_read<v_rd_off(D0, 1, 1)>(vb);
    const s16x4 l2 = tr_read<v_rd_off(D0, 2, 0)>(vb), h2 = tr_read<v_rd_off(D0, 2, 1)>(vb), l3 = tr_read<v_rd_off(D0, 3, 0)>(vb), h3 = tr_read<v_rd_off(D0, 3, 1)>(vb);
    asm volatile("s_waitcnt lgkmcnt(0)" ::: "memory"); SBAR();
#define PK(L, H) (bf16x8){L[0], L[1], L[2], L[3], H[0], H[1], H[2], H[3]}
    od = __builtin_amdgcn_mfma_f32_32x32x16_bf16(pa0, PK(l0, h0), od, 0, 0, 0);
    od = __builtin_amdgcn_mfma_f32_32x32x16_bf16(pa1, PK(l1, h1), od, 0, 0, 0);
    od = __builtin_amdgcn_mfma_f32_32x32x16_bf16(pa2, PK(l2, h2), od, 0, 0, 0);
    od = __builtin_amdgcn_mfma_f32_32x32x16_bf16(pa3, PK(l3, h3), od, 0, 0, 0);
#undef PK
}
DEVI void pv_d0(f32x16* o, int vb, bf16x8 pa0, bf16x8 pa1, bf16x8 pa2, bf16x8 pa3) {
    pv_one<0>(o[0], vb, pa0, pa1, pa2, pa3); pv_one<1>(o[1], vb, pa0, pa1, pa2, pa3); pv_one<2>(o[2], vb, pa0, pa1, pa2, pa3); pv_one<3>(o[3], vb, pa0, pa1, pa2, pa3);
}
DEVI void attn_unit(int l, int unit, char* lds) {
    KPARAMS(p);
    const int tid = TIDX, wid = tid >> 6, lane = tid & 63, r32 = lane & 31, hi = lane >> 5, c = wid >> 2, wq = wid & 3;
    const bf16_t* P = (const bf16_t*)(p.ws + WS_P); const bf16_t* CKB = (const bf16_t*)(p.ws + WS_CKB); const bf16_t* CVB = (const bf16_t*)(p.ws + WS_CVB);
    const bool smp = unit < 128; const int v = unit - 128;
    const int b = smp ? unit >> 6 : v >> 4, h = smp ? (unit >> 3) & 7 : (v >> 1) & 7, qb = smp ? unit & 7 : v & 1;
    const int NTL = smp ? 24 : 4, krow0 = smp ? MC + b * DSEQ : b * SEQ, qrow0 = krow0 + qb * 128;
    char* V_lds = lds; char* K_lds = lds + 2 * SHM_V;
    float* wsm = (float*)(lds + 2 * SHM_V + 2 * SHM_K) + wid * 64; float* li_l = wsm; float* al_l = wsm + 32;
    float m_reg = -1e30f, l_reg = 0; f32x16 o[4] = {}; bf16x8 qr[4];
    { const bf16_t* Qw = P + (size_t)(qrow0 + wq * 32 + r32) * IN_W + CQ + h * 128 + c * 64 + hi * 8;
#pragma unroll
      for (int d0 = 0; d0 < 4; ++d0) qr[d0] = *reinterpret_cast<const bf16x8*>(Qw + d0 * 16); }
    const int sr = tid >> 4, sc = (tid & 15) * 8, vst0 = v_st(sr, sc), vst1 = v_st(32 + sr, sc);
    const int vb0 = (int)(uintptr_t)V_lds + v_rd_base(lane);
    struct { bf16x8 vs0, vs1, ks0, ks1; } sr_[2];
#define KVPTR(j, kp, vp, st) do { if (smp && (j) < 8) { const size_t o_ = ((size_t)((b * 2 + l) * PAST + (j) * 64)) * 1024 + h * 128; kp = CKB + o_; vp = CVB + o_; st = 1024; } \
      else { const size_t o_ = (size_t)(krow0 + ((j) - (smp ? 8 : 0)) * 64) * IN_W + h * 128; kp = P + o_ + CK; vp = P + o_ + CV; st = IN_W; } } while (0)
#define SLOAD(i, j) do { const bf16_t* kp_; const bf16_t* vp_; int st_; KVPTR(j, kp_, vp_, st_); \
      sr_[i].vs0 = *reinterpret_cast<const bf16x8*>(vp_ + (size_t)sr * st_ + sc); sr_[i].vs1 = *reinterpret_cast<const bf16x8*>(vp_ + (size_t)(32 + sr) * st_ + sc); \
      sr_[i].ks0 = *reinterpret_cast<const bf16x8*>(kp_ + (size_t)sr * st_ + sc); sr_[i].ks1 = *reinterpret_cast<const bf16x8*>(kp_ + (size_t)(32 + sr) * st_ + sc); } while (0)
#define SWRITE(bb, i) do { *(bf16x8*)(V_lds + (bb) * SHM_V + vst0) = sr_[i].vs0; *(bf16x8*)(V_lds + (bb) * SHM_V + vst1) = sr_[i].vs1; const int kc = sc * 2; \
      *(bf16x8*)(K_lds + (bb) * SHM_K + KSWZ(sr, kc)) = sr_[i].ks0; *(bf16x8*)(K_lds + (bb) * SHM_K + KSWZ(32 + sr, kc)) = sr_[i].ks1; } while (0)
#define SWAIT() asm volatile("s_waitcnt vmcnt(4)" ::: "memory")
#define RESC(a) do { if (__any((a) < 1.f)) { if (hi == 0) al_l[r32] = (a); asm volatile("s_waitcnt lgkmcnt(0)" ::: "memory"); \
      _Pragma("unroll") for (int d = 0; d < 4; ++d) _Pragma("unroll") for (int r = 0; r < 16; ++r) o[d][r] *= al_l[crow(r, hi)]; } } while (0)
    f32x16 pA0, pA1, pB0, pB1; float mnA, mnB, alA, alB; bf16x8 pa0, pa1, pa2, pa3;
    constexpr int SE = 0, SO = 1;
    SLOAD(SE, 0); SLOAD(SO, 1); asm volatile("s_waitcnt vmcnt(4)" ::: "memory"); SWRITE(0, SE); __syncthreads();
    qkt(pA0, pA1, K_lds, qr, r32, hi, c); partialSM(pA0, pA1, m_reg, mnA, alA);
    if (2 < NTL) SLOAD(SE, 2);
    SWAIT(); SWRITE(1, SO); __syncthreads();
    for (int j = 1; j + 1 < NTL; j += 2) {
        SBAR(); qkt(pB0, pB1, K_lds + SHM_K, qr, r32, hi, c);
        finishSM(pA0, pA1, alA, l_reg, pa0, pa1, pa2, pa3); SBAR();
        SLOAD(SO, j + 2); SBAR();
        pv_d0(o, vb0, pa0, pa1, pa2, pa3); partialSM(pB0, pB1, m_reg, mnB, alB);
        __syncthreads(); SWAIT(); SWRITE(0, SE);
        RESC(alB); __syncthreads();
        SBAR(); qkt(pA0, pA1, K_lds, qr, r32, hi, c);
        finishSM(pB0, pB1, alB, l_reg, pa0, pa1, pa2, pa3); SBAR();
        if (j + 3 < NTL) SLOAD(SE, j + 3); SBAR();
        pv_d0(o, vb0 + SHM_V, pa0, pa1, pa2, pa3); partialSM(pA0, pA1, m_reg, mnA, alA);
        __syncthreads(); SWAIT(); SWRITE(1, SO);
        RESC(alA); __syncthreads();
    }
    SBAR(); qkt(pB0, pB1, K_lds + SHM_K, qr, r32, hi, c);
    finishSM(pA0, pA1, alA, l_reg, pa0, pa1, pa2, pa3); SBAR();
    pv_d0(o, vb0, pa0, pa1, pa2, pa3); partialSM(pB0, pB1, m_reg, mnB, alB);
    __syncthreads(); RESC(alB);
    finishSM(pB0, pB1, alB, l_reg, pa0, pa1, pa2, pa3); SBAR();
    pv_d0(o, vb0 + SHM_V, pa0, pa1, pa2, pa3);
    KPARAMS(pe);
    const int ql = tid >> 2, sg = (tid & 3) * 32; const size_t erow = (size_t)(qrow0 + ql);
    u32x4 ag[4]; f32x4 gv[8];
    { const bf16_t* agp = (const bf16_t*)(pe.ws + WS_P) + erow * IN_W + CAG + h * 128 + sg; const float* gp = pe.subln_g + l * 128 + sg;
#pragma unroll
      for (int q4 = 0; q4 < 4; ++q4) { ag[q4] = *(const u32x4*)(agp + q4 * 8); gv[2 * q4] = *(const f32x4*)(gp + q4 * 8); gv[2 * q4 + 1] = *(const f32x4*)(gp + q4 * 8 + 4); } }
    if (hi == 0) li_l[r32] = l_reg;
    asm volatile("s_waitcnt lgkmcnt(0)" ::: "memory");
    float rli[16];
    const float lamv = (c == 1) ? *(volatile float*)(lds + LDS_QSLOT + 32) : 1.f;
#pragma unroll
    for (int r = 0; r < 16; ++r) rli[r] = __builtin_amdgcn_rcpf(li_l[crow(r, hi)]) * lamv;
    __syncthreads();
    float* X = (float*)lds;
    if (c == 1) {
#pragma unroll
        for (int r = 0; r < 16; ++r)
#pragma unroll
            for (int d0 = 0; d0 < 4; ++d0) X[(wq * 32 + crow(r, hi)) * 132 + d0 * 32 + r32] = o[d0][r] * rli[r];
    }
    __syncthreads();
    if (c == 0) {
#pragma unroll
        for (int r = 0; r < 16; ++r) {
            const int qx = wq * 32 + crow(r, hi);
#pragma unroll
            for (int d0 = 0; d0 < 4; ++d0) X[qx * 132 + d0 * 32 + r32] = o[d0][r] * rli[r] - X[qx * 132 + d0 * 32 + r32];
        }
    }
    __syncthreads();
    {
        int lq = l; asm volatile("" : "+s"(lq));
        const float post = 1.0f - lam_init_of(lq);
        f32x4 xv[8]; float ss = 0.f;
#pragma unroll
        for (int q8 = 0; q8 < 8; ++q8) { xv[q8] = *(const f32x4*)(X + ql * 132 + sg + q8 * 4); ss += xv[q8][0] * xv[q8][0] + xv[q8][1] * xv[q8][1] + xv[q8][2] * xv[q8][2] + xv[q8][3] * xv[q8][3]; }
        ss += swz_xor<1>(ss); ss += swz_xor<2>(ss);
        const float rs = rsqrtf(ss * (1.0f / 128.0f) + 1e-6f) * post;
        bf16_t* mx = (bf16_t*)(pe.ws + WS_MIX) + erow * D + h * 128 + sg;
#pragma unroll
        for (int q4 = 0; q4 < 4; ++q4) {
            const f32x4 x0 = xv[2 * q4], x1 = xv[2 * q4 + 1], g0 = gv[2 * q4], g1 = gv[2 * q4 + 1];
            float ov[8];
#pragma unroll
            for (int e = 0; e < 4; ++e) { const float a0 = __uint_as_float(ag[q4][e] << 16), a1 = __uint_as_float(ag[q4][e] & 0xffff0000u);
                const float xa = (e < 2 ? x0[2 * e] : x1[2 * e - 4]), xb = (e < 2 ? x0[2 * e + 1] : x1[2 * e - 3]), ga = (e < 2 ? g0[2 * e] : g1[2 * e - 4]), gb = (e < 2 ? g0[2 * e + 1] : g1[2 * e - 3]);
                ov[2 * e] = xa * rs * ga * (a0 * lru_fsig(a0)); ov[2 * e + 1] = xb * rs * gb * (a1 * lru_fsig(a1)); }
            u32x4 w; w.x = pk2bf(ov[0], ov[1]); w.y = pk2bf(ov[2], ov[3]); w.z = pk2bf(ov[4], ov[5]); w.w = pk2bf(ov[6], ov[7]);
            *(u32x4*)(mx + q4 * 8) = w;
        }
    }
    __syncthreads();
#undef KVPTR
#undef SLOAD
#undef SWRITE
#undef SWAIT
#undef RESC
}
}
DEVI void ph_final(const Params& p) {
    const int wid = TIDX >> 6, lane = TIDX & 63, gw = blockIdx.x * (NT / 64) + wid, NGW = gridDim.x * (NT / 64);
    const bf16_t* XB = (const bf16_t*)(p.ws + WS_H);
    for (int row = gw; row < MT; row += NGW) {
        const bf16_t* xr = XB + (size_t)row * D; float* yr = p.out + (size_t)row * D;
        u32x4 v[4]; f32x4 g[8]; float ss = 0.f;
#pragma unroll
        for (int j = 0; j < 4; ++j) v[j] = *(const u32x4*)(xr + j * 512 + lane * 8);
#pragma unroll
        for (int j = 0; j < 4; ++j) { g[2 * j] = *(const f32x4*)(p.final_g + j * 512 + lane * 8); g[2 * j + 1] = *(const f32x4*)(p.final_g + j * 512 + lane * 8 + 4); }
        f32x4 x[8];
#pragma unroll
        for (int j = 0; j < 4; ++j) {
            x[2 * j] = (f32x4){__uint_as_float(v[j].x << 16), __uint_as_float(v[j].x & 0xffff0000u), __uint_as_float(v[j].y << 16), __uint_as_float(v[j].y & 0xffff0000u)};
            x[2 * j + 1] = (f32x4){__uint_as_float(v[j].z << 16), __uint_as_float(v[j].z & 0xffff0000u), __uint_as_float(v[j].w << 16), __uint_as_float(v[j].w & 0xffff0000u)};
        }
#pragma unroll
        for (int j = 0; j < 8; ++j) ss += x[j][0] * x[j][0] + x[j][1] * x[j][1] + x[j][2] * x[j][2] + x[j][3] * x[j][3];
        const float rs = rsqrtf(wave_sum(ss) * (1.0f / D) + 1e-6f);
#pragma unroll
        for (int j = 0; j < 4; ++j) { *(f32x4*)(yr + j * 512 + lane * 8) = x[2 * j] * rs * g[2 * j]; *(f32x4*)(yr + j * 512 + lane * 8 + 4) = x[2 * j + 1] * rs * g[2 * j + 1]; }
    }
}

namespace lru {
#define LBAR() do { asm volatile("s_waitcnt lgkmcnt(0)" ::: "memory"); __builtin_amdgcn_s_barrier(); asm volatile("" ::: "memory"); } while (0)
constexpr int L_W = 0, L_XCB = 36864, L_XCF = L_XCB + 9216, L_A = L_XCF + 64 * 68 * 4, L_B = L_A + 64 * 68 * 4, L_SEG = L_B + 64 * 68 * 4, L_C = L_SEG + 4096, L_END = L_C + 512;
DEVI float fsigmoid(float x) { return __builtin_amdgcn_rcpf(1.0f + __builtin_amdgcn_exp2f(-1.4426950408889634f * x)); }
DEVI void gate_ab(float ra, float ia, float sp8, float xc, float& a, float& bb) {
    const float r = fsigmoid(ra), ig = fsigmoid(ia), log_a = sp8 * r;
    a = __builtin_amdgcn_exp2f(1.4426950408889634f * log_a);
    const float om = fmaf(-a, a, 1.0f);
    bb = __builtin_amdgcn_sqrtf(om) * (ig * xc);
}
DEVI void gate_lb(float ra, float ia, float sp8, float xc, float& la, float& bb) {
    const float r = fsigmoid(ra), ig = fsigmoid(ia), log_a = sp8 * r;
    const float om = 1.0f - __builtin_amdgcn_exp2f(2.8853900817779268f * log_a);
    la = log_a; bb = __builtin_amdgcn_sqrtf(om) * (ig * xc);
}
template <bool REV> DEVI void scan_chunk(float* AL, float* BL, float* SEG, float* Cc, int ci, int sch, int seg) {
    float av[8], bv[8];
    { float A = 1.f, H = 0.f;
#pragma unroll
      for (int k = 0; k < 8; ++k) { const int pos = seg * 8 + k, tk = REV ? 63 - pos : pos; av[k] = AL[tk * 68 + sch]; bv[k] = BL[tk * 68 + sch]; H = av[k] * H + bv[k]; A *= av[k]; }
      SEG[(seg * 64 + sch) * 2] = A; SEG[(seg * 64 + sch) * 2 + 1] = H; }
    LBAR();
    float h = Cc[(ci & 1) * 64 + sch];
    for (int s2 = 0; s2 < seg; ++s2) h = SEG[(s2 * 64 + sch) * 2] * h + SEG[(s2 * 64 + sch) * 2 + 1];
#pragma unroll
    for (int k = 0; k < 8; ++k) { const int pos = seg * 8 + k, tk = REV ? 63 - pos : pos; h = av[k] * h + bv[k]; BL[tk * 68 + sch] = h; }
    if (seg == 7) Cc[((ci + 1) & 1) * 64 + sch] = h;
    LBAR();
}
DEVI void lru_unit(int l, int unit, char* lds) {
    KPARAMS(p);
    const int tid = TIDX, wid = tid >> 6, lane = tid & 63;
    const bool smp = unit < 16; const int v = unit - 16;
    const int b = smp ? unit >> 3 : v >> 3, n = smp ? unit & 7 : v & 7, L = smp ? DSEQ : SEQ, row0 = smp ? MC + b * DSEQ : b * SEQ, nchunk = L / 64;
    const bf16_t* P = (const bf16_t*)(p.ws + WS_P); bf16_t* MIX = (bf16_t*)(p.ws + WS_MIX);
    bf16_t* HS = (bf16_t*)(p.ws + WS_HS); unsigned* SAB = (unsigned*)(p.ws + WS_SA);
    bf16_t* Wl = (bf16_t*)(lds + L_W); bf16_t* XCB = (bf16_t*)(lds + L_XCB); float* XCF = (float*)(lds + L_XCF);
    float* AL = (float*)(lds + L_A); float* BL = (float*)(lds + L_B); float* SEG = (float*)(lds + L_SEG); float* Cc = (float*)(lds + L_C);
    __syncthreads();
    {
        const bf16_t* src = (const bf16_t*)(p.ws + WS_WGB) + (size_t)(l * 8 + n) * 16384;
#pragma unroll
        for (int i = 0; i < 4; ++i) { const int e = (i * 512 + tid) * 8, mat = e >> 12, d = (e >> 6) & 63, c = e & 63;
            *(u32x4*)(Wl + (mat * 64 + d) * 72 + c) = *(const u32x4*)(src + e); }
    }
    const int ct = tid >> 3, c8 = (tid & 7) * 8, chg = n * 64 + c8;
    const int db = wid & 3, mh = wid >> 2, fr = lane & 15, fq = lane >> 4, gd = db * 16 + fr, gch = n * 64 + gd;
    const int sch = tid & 63, seg = tid >> 6;
    if (tid < 64) Cc[tid] = smp ? p.state_lru[((b * 2 + l) * 2 + 0) * 512 + n * 64 + tid] : 0.f;
    float bav[2], biv[2], sp8[2];
#pragma unroll
    for (int dir = 0; dir < 2; ++dir) { bav[dir] = p.lru_ba[(l * 2 + dir) * 512 + gch]; biv[dir] = p.lru_bi[(l * 2 + dir) * 512 + gch]; sp8[dir] = -8.0f * log1pf(expf(-p.lru_lam[(l * 2 + dir) * 512 + gch])); }
    f32x4 cw0[4], cw1[4], cb0, cb1;
#pragma unroll
    for (int j = 0; j < 4; ++j) { cw0[j] = *(const f32x4*)(p.lru_conv_w + (l * 4 + j) * 512 + chg); cw1[j] = *(const f32x4*)(p.lru_conv_w + (l * 4 + j) * 512 + chg + 4); }
    cb0 = *(const f32x4*)(p.lru_conv_b + l * 512 + chg); cb1 = *(const f32x4*)(p.lru_conv_b + l * 512 + chg + 4);
    u32x4 xv[4], xn[4];
#define LX_LOAD(dst, tbase) do { _Pragma("unroll") for (int j = 0; j < 4; ++j) { const int tt = (tbase) + ct + j - 2; dst[j] = (u32x4){0u, 0u, 0u, 0u}; \
        if (tt >= 0 && tt < L) dst[j] = *(const u32x4*)(P + (size_t)(row0 + tt) * IN_W + CLX + chg); } } while (0)
    LX_LOAD(xv, 0);
#pragma unroll 1
    for (int ci = 0; ci < nchunk; ++ci) {
        const int t0 = ci * 64;
        if (ci + 1 < nchunk) LX_LOAD(xn, t0 + 64);
        {
            float xc[8];
#pragma unroll
            for (int e = 0; e < 4; ++e) { xc[e] = cb0[e]; xc[4 + e] = cb1[e]; }
#pragma unroll
            for (int j = 0; j < 4; ++j) {
#pragma unroll
                for (int e = 0; e < 4; ++e) { const unsigned wd = xv[j][e]; xc[2 * e] += (e < 2 ? cw0[j][2 * e] : cw1[j][2 * e - 4]) * __uint_as_float(wd << 16); xc[2 * e + 1] += (e < 2 ? cw0[j][2 * e + 1] : cw1[j][2 * e - 3]) * __uint_as_float(wd & 0xffff0000u); }
            }
            *(f32x4*)(XCF + ct * 68 + c8) = (f32x4){xc[0], xc[1], xc[2], xc[3]}; *(f32x4*)(XCF + ct * 68 + c8 + 4) = (f32x4){xc[4], xc[5], xc[6], xc[7]};
            u32x4 w; w.x = pk2bf(xc[0], xc[1]); w.y = pk2bf(xc[2], xc[3]); w.z = pk2bf(xc[4], xc[5]); w.w = pk2bf(xc[6], xc[7]);
            *(u32x4*)(XCB + ct * 72 + c8) = w;
        }
        LBAR();
        {
            f32x4 acc[2][4];
#pragma unroll
            for (int mt = 0; mt < 2; ++mt)
#pragma unroll
                for (int g = 0; g < 4; ++g) acc[mt][g] = (f32x4){0.f, 0.f, 0.f, 0.f};
#pragma unroll
            for (int ks = 0; ks < 2; ++ks) {
                bf16x8 af[2], bfr[4];
#pragma unroll
                for (int mt = 0; mt < 2; ++mt) af[mt] = *(const bf16x8*)(XCB + (mh * 32 + mt * 16 + fr) * 72 + ks * 32 + fq * 8);
#pragma unroll
                for (int g = 0; g < 4; ++g) bfr[g] = *(const bf16x8*)(Wl + (g * 64 + gd) * 72 + ks * 32 + fq * 8);
#pragma unroll
                for (int mt = 0; mt < 2; ++mt)
#pragma unroll
                    for (int g = 0; g < 4; ++g) acc[mt][g] = __builtin_amdgcn_mfma_f32_16x16x32_bf16(af[mt], bfr[g], acc[mt][g], 0, 0, 0);
            }
#pragma unroll
            for (int mt = 0; mt < 2; ++mt)
#pragma unroll
                for (int j = 0; j < 4; ++j) {
                    const int tk = mh * 32 + mt * 16 + fq * 4 + j; const float xc = XCF[tk * 68 + gd];
                    float a, bb;
                    gate_ab(acc[mt][0][j] + bav[0], acc[mt][1][j] + biv[0], sp8[0], xc, a, bb);
                    AL[tk * 68 + gd] = a; BL[tk * 68 + gd] = bb;
                    float la; gate_lb(acc[mt][2][j] + bav[1], acc[mt][3][j] + biv[1], sp8[1], xc, la, bb);
                    SAB[(size_t)(row0 + t0 + tk) * 512 + gch] = pk2bf(la, bb);
                }
        }
        LBAR();
        scan_chunk<false>(AL, BL, SEG, Cc, ci, sch, seg);
        {
            const f32x4 h0 = *(const f32x4*)(BL + ct * 68 + c8), h1 = *(const f32x4*)(BL + ct * 68 + c8 + 4);
            u32x4 w; w.x = pk2bf(h0[0], h0[1]); w.y = pk2bf(h0[2], h0[3]); w.z = pk2bf(h1[0], h1[1]); w.w = pk2bf(h1[2], h1[3]);
            *(u32x4*)(HS + (size_t)(row0 + t0 + ct) * 512 + chg) = w;
        }
#pragma unroll
        for (int j = 0; j < 4; ++j) xv[j] = xn[j];
    }
#undef LX_LOAD
    __syncthreads();
    if (tid < 64) {
        if (!smp) p.out[OUT_ST + ((size_t)(b * 2 + l) * 2 + 0) * 512 + n * 64 + tid] = Cc[(nchunk & 1) * 64 + tid];
        Cc[tid] = smp ? p.state_lru[((b * 2 + l) * 2 + 1) * 512 + n * 64 + tid] : 0.f;
    }
    asm volatile("s_waitcnt vmcnt(0)" ::: "memory");
    __syncthreads();
    u32x4 qab[2], nab[2], qh, nh, qg, ng;
#define P2_LOAD(AB_, H_, G_, chunk_) do { const size_t r_ = (size_t)(row0 + (chunk_) * 64 + ct); const unsigned* sab_ = SAB + r_ * 512 + chg; \
        AB_[0] = *(const u32x4*)sab_; AB_[1] = *(const u32x4*)(sab_ + 4); H_ = *(const u32x4*)(HS + r_ * 512 + chg); \
        G_ = *(const u32x4*)(P + r_ * IN_W + CLG + chg); } while (0)
    P2_LOAD(qab, qh, qg, nchunk - 1);
#pragma unroll 1
    for (int ci = 0; ci < nchunk; ++ci) {
        const int t0 = (nchunk - 1 - ci) * 64; const size_t row = (size_t)(row0 + t0 + ct);
        if (ci + 1 < nchunk) P2_LOAD(nab, nh, ng, nchunk - 2 - ci);
#pragma unroll
        for (int hf = 0; hf < 2; ++hf) { f32x4 av, bv;
#pragma unroll
            for (int e = 0; e < 4; ++e) { av[e] = __builtin_amdgcn_exp2f(1.4426950408889634f * __uint_as_float(qab[hf][e] << 16)); bv[e] = __uint_as_float(qab[hf][e] & 0xffff0000u); }
            *(f32x4*)(AL + ct * 68 + c8 + 4 * hf) = av; *(f32x4*)(BL + ct * 68 + c8 + 4 * hf) = bv; }
        LBAR();
        scan_chunk<true>(AL, BL, SEG, Cc, ci, sch, seg);
        {
            const f32x4 h0 = *(const f32x4*)(BL + ct * 68 + c8), h1 = *(const f32x4*)(BL + ct * 68 + c8 + 4);
            float o[8];
#pragma unroll
            for (int e = 0; e < 4; ++e) { const float s0 = __uint_as_float(qh[e] << 16) + (e < 2 ? h0[2 * e] : h1[2 * e - 4]), s1 = __uint_as_float(qh[e] & 0xffff0000u) + (e < 2 ? h0[2 * e + 1] : h1[2 * e - 3]);
                const float g0 = __uint_as_float(qg[e] << 16), g1 = __uint_as_float(qg[e] & 0xffff0000u);
                o[2 * e] = s0 * g0 * fsigmoid(g0); o[2 * e + 1] = s1 * g1 * fsigmoid(g1); }
            u32x4 w; w.x = pk2bf(o[0], o[1]); w.y = pk2bf(o[2], o[3]); w.z = pk2bf(o[4], o[5]); w.w = pk2bf(o[6], o[7]);
            *(u32x4*)(MIX + row * D + 1024 + chg) = w;
        }
        LBAR();
#pragma unroll
        for (int e = 0; e < 2; ++e) qab[e] = nab[e];
        qh = nh; qg = ng;
    }
#undef P2_LOAD
    if (!smp && tid < 64) p.out[OUT_ST + ((size_t)(b * 2 + l) * 2 + 1) * 512 + n * 64 + tid] = Cc[(nchunk & 1) * 64 + tid];
    __syncthreads();
}
}

namespace hy {
constexpr int L_ZERO = 36864, L_YT = 40960, L_R = 110592;
template <bool SMP> DEVI void hy_unit_t(int l, int unit, char* lds) {
    constexpr int NCH = SMP ? 4 : 8, NSEQ = SMP ? 2 : 8, L = SMP ? DSEQ : SEQ, NBLK = L / 32, SEQSTRIDE = L * 2 + (L >> 7) * 16;
    KPARAMS(p);
    const int tid = TIDX, wid = tid >> 6, lane = tid & 63, r32 = lane & 31, hi = lane >> 5;
    const int c0 = SMP ? unit * 4 : (unit >> 2) * 8, row0 = SMP ? MC : (unit & 3) * 2048;
    const bf16_t* PHY = (const bf16_t*)(p.ws + WS_PH); bf16_t* MIX = (bf16_t*)(p.ws + WS_MIX);
    char* VT = lds; float* Yt = (float*)(lds + L_YT);
    const int tok0 = tid * 4, sq = tok0 / L, s0 = tok0 % L;
    __syncthreads();
    if (tid < 4) ((unsigned*)(lds + L_ZERO))[tid] = 0u;
    {
        const bf16_t* GSu = (const bf16_t*)(p.ws + WS_GS) + (size_t)l * GS_PER_LAYER + (SMP ? GS_L256 : 0) + (size_t)c0 * 2 * L;
#pragma unroll
        for (int q = 0; q < (NCH * 2 * L / 8) / NT; ++q) *(u32x4*)(lds + L_R + (q * NT + tid) * 16) = *(const u32x4*)(GSu + (size_t)(q * NT + tid) * 8);
    }
    {
        float xh[6][NCH], x1[6][NCH];
#pragma unroll
        for (int rr = 0; rr < 6; ++rr) {
            const int ss = s0 + rr - 1; const bool ok = ss >= 0 && ss < L;
            const bf16_t* src = PHY + ((size_t)(c0 >> 3) * MT + (row0 + tok0 + rr - 1)) * 8 + (c0 & 7);
            constexpr size_t KIND = (size_t)64 * MT * 8;
            if (SMP) { uint2 a = make_uint2(0u, 0u), b = a; if (ok) { a = *(const uint2*)src; b = *(const uint2*)(src + KIND); }
                xh[rr][0] = __uint_as_float(a.x << 16); xh[rr][1] = __uint_as_float(a.x & 0xffff0000u); xh[rr][2] = __uint_as_float(a.y << 16); xh[rr][3] = __uint_as_float(a.y & 0xffff0000u);
                x1[rr][0] = __uint_as_float(b.x << 16); x1[rr][1] = __uint_as_float(b.x & 0xffff0000u); x1[rr][2] = __uint_as_float(b.y << 16); x1[rr][3] = __uint_as_float(b.y & 0xffff0000u); }
            else { u32x4 a = {0u, 0u, 0u, 0u}, b = a; if (ok) { a = *(const u32x4*)src; b = *(const u32x4*)(src + KIND); }
#pragma unroll
                for (int e = 0; e < 4; ++e) { xh[rr][2 * e] = __uint_as_float(a[e] << 16); xh[rr][2 * e + 1] = __uint_as_float(a[e] & 0xffff0000u); x1[rr][2 * e] = __uint_as_float(b[e] << 16); x1[rr][2 * e + 1] = __uint_as_float(b[e] & 0xffff0000u); } }
        }
#pragma unroll
        for (int c = 0; c < NCH; ++c) {
            const int ch = c0 + c;
            const float bh = p.hy_conv_b[l * 1536 + ch], b1 = p.hy_conv_b[l * 1536 + 512 + ch];
            const float wh0 = p.hy_conv_w[(l * 3 + 0) * 1536 + ch], wh1 = p.hy_conv_w[(l * 3 + 1) * 1536 + ch], wh2 = p.hy_conv_w[(l * 3 + 2) * 1536 + ch];
            const float w10 = p.hy_conv_w[(l * 3 + 0) * 1536 + 512 + ch], w11 = p.hy_conv_w[(l * 3 + 1) * 1536 + 512 + ch], w12 = p.hy_conv_w[(l * 3 + 2) * 1536 + 512 + ch];
            float v[4];
#pragma unroll
            for (int e = 0; e < 4; ++e) v[e] = (bh + wh0 * xh[e][c] + wh1 * xh[e + 1][c] + wh2 * xh[e + 2][c]) * (b1 + w10 * x1[e][c] + w11 * x1[e + 1][c] + w12 * x1[e + 2][c]);
            *(uint2*)(VT + (c * NSEQ + sq) * SEQSTRIDE + s0 * 2 + (s0 >> 7) * 16) = make_uint2(pk2bf(v[0], v[1]), pk2bf(v[2], v[3]));
        }
    }
    __syncthreads();
    typedef typename std::conditional<SMP, uint2, u32x4>::type raw_t;
    raw_t xr[6], gr[4];
#pragma unroll
    for (int rr = 0; rr < 6; ++rr) { const int ss = s0 + rr - 1; xr[rr] = raw_t{}; if (ss >= 0 && ss < L) xr[rr] = *(const raw_t*)(PHY + ((size_t)(128 + (c0 >> 3)) * MT + (row0 + tok0 + rr - 1)) * 8 + (c0 & 7)); }
#pragma unroll
    for (int e = 0; e < 4; ++e) gr[e] = *(const raw_t*)(PHY + ((size_t)(192 + (c0 >> 3)) * MT + (row0 + tok0 + e)) * 8 + (c0 & 7));
    {
        const int wch = SMP ? wid >> 1 : wid;
        const unsigned* Rd = (const unsigned*)(lds + L_R) + wch * L;
        constexpr int NTW = SMP ? 1 : 2;
        att::f32x16 acc[NTW];
#pragma unroll
        for (int nt = 0; nt < NTW; ++nt) acc[nt] = att::f32x16{};
        int vbase[NTW], iblk[NTW];
#pragma unroll
        for (int nt = 0; nt < NTW; ++nt) {
            const int colg = SMP ? (wid & 1) * 32 + r32 : nt * 32 + r32, seq = SMP ? colg >> 5 : colg >> 3;
            iblk[nt] = SMP ? colg & 31 : colg & 7; vbase[nt] = (wch * NSEQ + seq) * SEQSTRIDE + hi * 16;
        }
        const int abase = L - 1 - r32 + 8 * hi;
        const unsigned ash = (unsigned)(abase & 1) * 16u;
#pragma unroll 4
        for (int k = -(NBLK - 1); k <= NBLK - 1; ++k) {
#pragma unroll
            for (int ks = 0; ks < 2; ++ks) {
                const unsigned* dp = Rd + ((abase - 32 * k + 16 * ks) >> 1);
                const unsigned d0 = dp[0], d1 = dp[1], d2 = dp[2], d3 = dp[3], d4 = dp[4];
                u32x4 aw; aw.x = __builtin_amdgcn_alignbit(d1, d0, ash); aw.y = __builtin_amdgcn_alignbit(d2, d1, ash); aw.z = __builtin_amdgcn_alignbit(d3, d2, ash); aw.w = __builtin_amdgcn_alignbit(d4, d3, ash);
                const bf16x8 A = __builtin_bit_cast(bf16x8, aw);
#pragma unroll
                for (int nt = 0; nt < NTW; ++nt) {
                    const int src = iblk[nt] - k; const bool ok = src >= 0 && src < NBLK;
                    const int sidx = 32 * src + 16 * ks;
                    const int off = ok ? vbase[nt] + sidx * 2 + (sidx >> 7) * 16 : L_ZERO;
                    const bf16x8 B = *(const bf16x8*)(lds + off);
                    acc[nt] = __builtin_amdgcn_mfma_f32_32x32x16_bf16(A, B, acc[nt], 0, 0, 0);
                }
            }
        }
#pragma unroll
        for (int nt = 0; nt < NTW; ++nt) {
            const int colg = SMP ? (wid & 1) * 32 + r32 : nt * 32 + r32;
#pragma unroll
            for (int r = 0; r < 16; ++r) Yt[(wch * 64 + colg) * 33 + att::crow(r, hi)] = acc[nt][r];
        }
    }
    __syncthreads();
    {
        float x0[6][NCH];
#pragma unroll
        for (int rr = 0; rr < 6; ++rr) {
            if constexpr (SMP) { const uint2 a = xr[rr];
                x0[rr][0] = __uint_as_float(a.x << 16); x0[rr][1] = __uint_as_float(a.x & 0xffff0000u); x0[rr][2] = __uint_as_float(a.y << 16); x0[rr][3] = __uint_as_float(a.y & 0xffff0000u); }
            else { const u32x4 a = xr[rr];
#pragma unroll
                for (int e = 0; e < 4; ++e) { x0[rr][2 * e] = __uint_as_float(a[e] << 16); x0[rr][2 * e + 1] = __uint_as_float(a[e] & 0xffff0000u); } }
        }
        float w0[NCH], w1[NCH], w2[NCH], bb[NCH];
#pragma unroll
        for (int c = 0; c < NCH; ++c) { const int ch = 1024 + c0 + c; bb[c] = p.hy_conv_b[l * 1536 + ch]; w0[c] = p.hy_conv_w[(l * 3 + 0) * 1536 + ch]; w1[c] = p.hy_conv_w[(l * 3 + 1) * 1536 + ch]; w2[c] = p.hy_conv_w[(l * 3 + 2) * 1536 + ch]; }
        const int blk = tok0 >> 5, a0 = tok0 & 31;
#pragma unroll
        for (int e = 0; e < 4; ++e) {
            const size_t row = (size_t)(row0 + tok0 + e);
            float o[NCH];
            if constexpr (SMP) { const uint2 g = gr[e]; const float hg[4] = {__uint_as_float(g.x << 16), __uint_as_float(g.x & 0xffff0000u), __uint_as_float(g.y << 16), __uint_as_float(g.y & 0xffff0000u)};
#pragma unroll
                for (int c = 0; c < NCH; ++c) o[c] = (bb[c] + w0[c] * x0[e][c] + w1[c] * x0[e + 1][c] + w2[c] * x0[e + 2][c]) * Yt[(c * 64 + blk) * 33 + a0 + e] * (hg[c] * lru::fsigmoid(hg[c]));
                *(uint2*)(MIX + row * D + 1536 + c0) = make_uint2(pk2bf(o[0], o[1]), pk2bf(o[2], o[3])); }
            else { const u32x4 g = gr[e];
#pragma unroll
                for (int c = 0; c < NCH; ++c) { const float hg = (c & 1) ? __uint_as_float(g[c >> 1] & 0xffff0000u) : __uint_as_float(g[c >> 1] << 16);
                    o[c] = (bb[c] + w0[c] * x0[e][c] + w1[c] * x0[e + 1][c] + w2[c] * x0[e + 2][c]) * Yt[(c * 64 + blk) * 33 + a0 + e] * (hg * lru::fsigmoid(hg)); }
                u32x4 w; w.x = pk2bf(o[0], o[1]); w.y = pk2bf(o[2], o[3]); w.z = pk2bf(o[4], o[5]); w.w = pk2bf(o[6], o[7]);
                *(u32x4*)(MIX + row * D + 1536 + c0) = w; }
        }
    }
}
DEVI void hy_unit(int l, int unit, char* lds) { if (unit < 128) hy_unit_t<true>(l, unit, lds); else hy_unit_t<false>(l, unit - 128, lds); }
}

constexpr int Q_N0 = 640, Q_N1 = 272, Q_N2 = 384;
DEVI void ph_mix(const Params& p, int l, char* lds) {
    const int tid = TIDX, lane = tid & 63;
    const float d1 = wave_sum(p.lam_q1[l * 64 + lane] * p.lam_k1[l * 64 + lane]), d2 = wave_sum(p.lam_q2[l * 64 + lane] * p.lam_k2[l * 64 + lane]);
    if (tid == 0) *(volatile float*)(lds + LDS_QSLOT + 32) = expf(d1) - expf(d2) + lam_init_of(l);
    unsigned* qctr = (unsigned*)(p.ws + WS_CTL) + 1024 + 256 * l;
    volatile int* slot = (volatile int*)(lds + LDS_QSLOT);
    bool first = true;
    for (;;) {
        int it;
        if (first) { it = (int)blockIdx.x; first = false; }
        else {
            __syncthreads();
            if (tid == 0) *slot = (int)(gridDim.x + __hip_atomic_fetch_add(qctr, 1u, __ATOMIC_RELAXED, __HIP_MEMORY_SCOPE_AGENT));
            __syncthreads();
            it = __builtin_amdgcn_readfirstlane(*slot);
        }
        if (it >= Q_N0 + Q_N1 + Q_N2) break;
        const int kind = it < 16 ? 1 : (it < 144 ? 0 : (it < 400 ? 1 : (it < 784 ? 2 : 0)));
        const int unit = it < 16 ? it : (it < 144 ? it - 16 : (it < 400 ? it - 144 + 16 : (it < 784 ? it - 400 : it - 784 + 128)));
        if (kind == 0) att::attn_unit(l, unit, lds);
        else if (kind == 1) lru::lru_unit(l, unit, lds);
        else hy::hy_unit(l, unit, lds);
    }
}

#define XB_TMO      128
#define XB_XCNT(j)  (256  + 64 * (j))
#define XB_XSUB(j)  (1280 + 64 * (j))
#define XB_XGEN(j)  (2304 + 64 * (j))
#define XB_TOP      3328
#define XB_TOPGEN   3392
#define XCD_BAR_WORDS 3456
#define XB_SPIN_CAP (1u << 18)
DEVI unsigned xb_ld(unsigned* p)              { return __hip_atomic_load(p, __ATOMIC_RELAXED, __HIP_MEMORY_SCOPE_AGENT); }
DEVI unsigned xb_add(unsigned* p, unsigned v) { return __hip_atomic_fetch_add(p, v, __ATOMIC_RELAXED, __HIP_MEMORY_SCOPE_AGENT); }
DEVI unsigned xb_xcc_id() { return (unsigned)__builtin_amdgcn_s_getreg((3 << 11) | 20) & 0xFu; }
#define XB_SPIN(cond, bar) do { unsigned _sp = 0; while (cond) { __builtin_amdgcn_s_sleep(1); \
    if ((++_sp & 255u) == 0u) { if (xb_ld(&(bar)[XB_TMO])) break; if (_sp > XB_SPIN_CAP) { atomicAdd(&(bar)[XB_TMO], 1u); break; } } } } while (0)
struct XcdBarrier { unsigned* bar; unsigned x; volatile LAS unsigned* st; };
DEVI XcdBarrier xcd_barrier_post(unsigned* bar, volatile LAS unsigned* st) {
    XcdBarrier b; b.bar = bar; b.x = xb_xcc_id(); b.st = st;
    if (threadIdx.x == 0) (void)xb_add(&bar[XB_XCNT(b.x)], 1u);
    return b;
}
DEVI void xcd_barrier_complete(unsigned* bar, unsigned x, unsigned& nloc, unsigned& nx) {
    const unsigned G = gridDim.x * gridDim.y * gridDim.z;
    unsigned sum, cnt, mine, sp = 0u;
    for (;;) {
        sum = 0u; cnt = 0u; mine = 0u;
#pragma unroll
        for (unsigned j = 0; j < 16; ++j) { const unsigned c = xb_ld(&bar[XB_XCNT(j)]); sum += c; cnt += (c > 0u) ? 1u : 0u; mine = (j == x) ? c : mine; }
        if (sum == G) break;
        __builtin_amdgcn_s_sleep(1);
        if ((++sp & 255u) == 0u) { if (xb_ld(&bar[XB_TMO])) break; if (sp > XB_SPIN_CAP) { atomicAdd(&bar[XB_TMO], 1u); break; } }
    }
    nloc = mine > 0u ? mine : 1u; nx = cnt > 0u ? cnt : 1u;
}
DEVI void xcd_barrier(const XcdBarrier& b) {
    asm volatile("s_waitcnt vmcnt(0)" ::: "memory");
    __syncthreads();
    if (threadIdx.x == 0) {
        unsigned* bar = b.bar;
        __builtin_amdgcn_s_waitcnt(0);
        unsigned nloc = b.st[0], nx = b.st[1];
        if (nloc == 0u) { xcd_barrier_complete(bar, b.x, nloc, nx); b.st[0] = nloc; b.st[1] = nx; }
        const unsigned old = xb_add(&bar[XB_XSUB(b.x)], 1u);
        asm volatile("buffer_inv sc1" ::: "memory");
        const unsigned gen = old / nloc;
        if (old + 1u == (gen + 1u) * nloc) {
            __builtin_amdgcn_fence(__ATOMIC_RELEASE, "agent");
            asm volatile("s_waitcnt vmcnt(0)" ::: "memory");
            const unsigned og = xb_add(&bar[XB_TOP], 1u);
            const unsigned tg = og / nx;
            if (og + 1u == (tg + 1u) * nx) {
#pragma unroll
                for (unsigned j = 0; j < 16; ++j) (void)__hip_atomic_fetch_add(&bar[XB_XGEN(j)], 1u, __ATOMIC_RELAXED, __HIP_MEMORY_SCOPE_AGENT);
            } else XB_SPIN(xb_ld(&bar[XB_XGEN(b.x)]) == gen, bar);
            asm volatile("s_waitcnt vmcnt(0)" ::: "memory");
        } else {
            XB_SPIN(xb_ld(&bar[XB_XGEN(b.x)]) == gen, bar);
            asm volatile("s_waitcnt vmcnt(0)" ::: "memory");
        }
    }
    __syncthreads();
}

struct EpiKeep {
    static constexpr bool PERM = true;
    f32x4 (&xk)[2][2][4][2]; Unit& uo;
    DEVI void operator()(const f32x4 (&acc)[2][2][4][2], const Unit& u, int wr, int wc, int fr, int fq) const {
        KPARAMS(pe); const float* MOD = (const float*)(pe.ws + WS_MOD);
        const int rloc = wr * 64 + fr, row0 = u.pm * BM + rloc, col0 = u.pn * BM + wc * 32 + 8 * fq, cond = cond_of_row(u.pm * BM);
        const float* gate = MOD + (size_t)(3 + cond) * 6144 + 4096 + col0;
        const bf16_t* Xb = xb_rows(pe.ws, u.pm * BM) + (size_t)rloc * D + col0;
        f32x4 g[2][2];
#pragma unroll
        for (int bj = 0; bj < 2; ++bj)
#pragma unroll
            for (int n = 0; n < 2; ++n) g[bj][n] = *(const f32x4*)(gate + bj * HALF + 4 * n);
        float ss[2][4] = {{0.f, 0.f, 0.f, 0.f}, {0.f, 0.f, 0.f, 0.f}};
#pragma unroll
        for (int bj = 0; bj < 2; ++bj)
#pragma unroll
            for (int ai = 0; ai < 2; ++ai) {
                const size_t o = (size_t)(ai * HALF) * D + bj * HALF; u32x4 xr[4];
#pragma unroll
                for (int i = 0; i < 4; ++i) xr[i] = *(const u32x4*)(Xb + o + (size_t)(i * 16) * D);
#pragma unroll
                for (int i = 0; i < 4; ++i) {
                    const f32x4 x0 = {__uint_as_float(xr[i].x << 16), __uint_as_float(xr[i].x & 0xffff0000u), __uint_as_float(xr[i].y << 16), __uint_as_float(xr[i].y & 0xffff0000u)};
                    const f32x4 x1 = {__uint_as_float(xr[i].z << 16), __uint_as_float(xr[i].z & 0xffff0000u), __uint_as_float(xr[i].w << 16), __uint_as_float(xr[i].w & 0xffff0000u)};
                    const f32x4 y0 = x0 + g[bj][0] * acc[ai][bj][i][0], y1 = x1 + g[bj][1] * acc[ai][bj][i][1];
                    xk[ai][bj][i][0] = y0; xk[ai][bj][i][1] = y1;
                    ss[ai][i] += y0[0] * y0[0] + y0[1] * y0[1] + y0[2] * y0[2] + y0[3] * y0[3] + y1[0] * y1[0] + y1[1] * y1[1] + y1[2] * y1[2] + y1[3] * y1[3];
                }
            }
        float* SS2 = (float*)(pe.ws + WS_SS2) + row0;
#pragma unroll
        for (int ai = 0; ai < 2; ++ai)
#pragma unroll
            for (int m = 0; m < 4; ++m) out_ss(ss[ai][m], SS2 + ai * HALF + m * 16, fq);
        uo = u;
    }
};
struct EpiKeepQ {
    f32x4 (&xq)[4][2]; int rbase, cbase;
    DEVI void operator()(const f32x4 (&acc)[4][2], int wr, int wc, int fr, int fq) const {
        KPARAMS(pe); const float* MOD = (const float*)(pe.ws + WS_MOD);
        const int row0 = rbase + wr * 64 + fr, col0 = cbase + wc * 32 + 8 * fq, cond = cond_of_row(rbase);
        const float* gate = MOD + (size_t)(3 + cond) * 6144 + 4096 + col0;
        const bf16_t* Xb = xb_rows(pe.ws, rbase) + (size_t)(row0 - rbase) * D + col0;
        const f32x4 g0 = *(const f32x4*)gate, g1 = *(const f32x4*)(gate + 4);
        u32x4 xr[4]; float ss[4] = {0.f, 0.f, 0.f, 0.f};
#pragma unroll
        for (int i = 0; i < 4; ++i) xr[i] = *(const u32x4*)(Xb + (size_t)(i * 16) * D);
#pragma unroll
        for (int i = 0; i < 4; ++i) {
            const f32x4 x0 = {__uint_as_float(xr[i].x << 16), __uint_as_float(xr[i].x & 0xffff0000u), __uint_as_float(xr[i].y << 16), __uint_as_float(xr[i].y & 0xffff0000u)};
            const f32x4 x1 = {__uint_as_float(xr[i].z << 16), __uint_as_float(xr[i].z & 0xffff0000u), __uint_as_float(xr[i].w << 16), __uint_as_float(xr[i].w & 0xffff0000u)};
            const f32x4 y0 = x0 + g0 * acc[i][0], y1 = x1 + g1 * acc[i][1];
            xq[i][0] = y0; xq[i][1] = y1;
            ss[i] += y0[0] * y0[0] + y0[1] * y0[1] + y0[2] * y0[2] + y0[3] * y0[3] + y1[0] * y1[0] + y1[1] * y1[1] + y1[2] * y1[2] + y1[3] * y1[3];
        }
        float* SS2 = (float*)(pe.ws + WS_SS2) + row0;
#pragma unroll
        for (int i = 0; i < 4; ++i) out_ss(ss[i], SS2 + i * 16, fq);
    }
};
DEVI void ph_out_final(const Params& p, char* lds) {
    XcdBarrier xb_; xb_.bar = (unsigned*)(p.ws + WS_CTL) + 4096; xb_.x = xb_xcc_id(); xb_.st = (volatile LAS unsigned*)(lds + LDS_QSLOT + 16);
    if (gridDim.x != 256) { ph_gemm_out(p, 1, lds); xcd_barrier(xb_); ph_final(p); return; }
    f32x4 xk[2][2][4][2], xq[4][2]; Unit uo; uo.pm = 0; uo.pn = 0;
    { EpiKeep e{xk, uo};
      StaticOrder S; S.init(MC, D, gridDim.x, blockIdx.x);
      gemm_phase((LAS unsigned char*)lds, (const bf16_t*)(p.ws + WS_MIX), (const bf16_t*)(p.ws + WS_WOUTT) + (size_t)D * D, D, S, e); }
    const int q = blockIdx.x, x = q & 7, s = (q >> 3) & 31, qm = 4 * (x >> 1) + (s & 3), qn = 8 * (x & 1) + (s >> 2), rbase = MC + qm * HALF, cbase = qn * HALF;
    { EpiKeepQ eq{xq, rbase, cbase};
      gemm_quarter((LAS unsigned char*)lds, (const bf16_t*)(p.ws + WS_MIX) + (size_t)rbase * D, (const bf16_t*)(p.ws + WS_WOUTT) + (size_t)D * D + (size_t)cbase * D, D, eq); }
    xcd_barrier(xb_);
    const int tid = TIDX, wid = tid >> 6, lane = tid & 63, wr = wid >> 2, wc = wid & 3, fr = lane & 15, fq = lane >> 4;
    const float* SS2 = (const float*)(p.ws + WS_SS2);
    {
        const int row0 = uo.pm * BM + wr * 64 + fr, col0 = uo.pn * BM + wc * 32 + 8 * fq;
        float rs[2][4]; f32x4 gf[2][2];
#pragma unroll
        for (int ai = 0; ai < 2; ++ai)
#pragma unroll
            for (int m = 0; m < 4; ++m) rs[ai][m] = rsqrtf(SS2[row0 + ai * HALF + m * 16] * (1.0f / D) + 1e-6f);
#pragma unroll
        for (int bj = 0; bj < 2; ++bj)
#pragma unroll
            for (int n = 0; n < 2; ++n) gf[bj][n] = *(const f32x4*)(p.final_g + col0 + bj * HALF + 4 * n);
#pragma unroll
        for (int ai = 0; ai < 2; ++ai)
#pragma unroll
            for (int m = 0; m < 4; ++m)
#pragma unroll
                for (int bj = 0; bj < 2; ++bj) { float* o = p.out + (size_t)(row0 + ai * HALF + m * 16) * D + col0 + bj * HALF;
                    *(f32x4*)o = xk[ai][bj][m][0] * rs[ai][m] * gf[bj][0]; *(f32x4*)(o + 4) = xk[ai][bj][m][1] * rs[ai][m] * gf[bj][1]; }
    }
    {
        const int row0 = rbase + wr * 64 + fr, col0 = cbase + wc * 32 + 8 * fq;
        float rs[4];
#pragma unroll
        for (int i = 0; i < 4; ++i) rs[i] = rsqrtf(SS2[row0 + i * 16] * (1.0f / D) + 1e-6f);
        const f32x4 gf0 = *(const f32x4*)(p.final_g + col0), gf1 = *(const f32x4*)(p.final_g + col0 + 4);
#pragma unroll
        for (int i = 0; i < 4; ++i) { float* o = p.out + (size_t)(row0 + i * 16) * D + col0; *(f32x4*)o = xq[i][0] * rs[i] * gf0; *(f32x4*)(o + 4) = xq[i][1] * rs[i] * gf1; }
    }
}

#if defined(__HIP_DEVICE_COMPILE__)
#define PH(call) do { const Params p = *kparams(); call; } while (0)
#else
#define PH(call) do { const Params& p = p_; call; } while (0)
#endif
__global__ void __launch_bounds__(NT, 2) mega(Params p_) {
    extern __shared__ __attribute__((aligned(16))) char lds[];
    volatile LAS unsigned* bst = (volatile LAS unsigned*)(lds + LDS_QSLOT + 16);
    if (threadIdx.x == 0) { bst[0] = 0u; bst[1] = 0u; }
    if ((threadIdx.x & 63) == 0) ((volatile LAS int*)(lds + LDS_WTAB))[(unsigned)__builtin_amdgcn_s_getreg((5 << 11) | 4) & 63u] = threadIdx.x >> 6;
    __syncthreads();
#if defined(__HIP_DEVICE_COMPILE__)
    { const Params p = *kparams(); (void)xcd_barrier_post((unsigned*)(p.ws + WS_CTL) + 4096, bst); }
#define GSYNC() do { const Params p = *kparams(); XcdBarrier xb_; xb_.bar = (unsigned*)(p.ws + WS_CTL) + 4096; xb_.x = xb_xcc_id(); xb_.st = (volatile LAS unsigned*)(lds + LDS_QSLOT + 16); xcd_barrier(xb_); } while (0)
#else
#define GSYNC() do { } while (0)
#endif
    PH(ph_prep(p, lds));
    PH(ph_mods_wait(p));
    if (p_.out == nullptr) cooperative_groups::this_grid().sync();
#define LAYER(l) do { if ((l) == 0) { PH(ph_norm(p, l)); GSYNC(); } PH(ph_gemm_in(p, l, lds)); PH(ph_filler(p, lds, (l) == 0 ? 0 : 2)); GSYNC(); PH(ph_mix(p, l, lds)); if ((l) == 0) PH(ph_filler(p, lds, 1)); GSYNC(); PH(ph_gemm_out(p, l, lds)); if ((l) == 0) PH(ph_filler(p, lds, 1)); GSYNC(); } while (0)
    LAYER(0);
    PH(ph_gemm_in(p, 1, lds)); PH(ph_filler(p, lds, 2)); GSYNC(); PH(ph_mix(p, 1, lds)); GSYNC();
    PH(ph_out_final(p, lds));
}

extern "C" void kernel_launch(void* const* d_in, const int* in_sizes, int n_in, void* d_out, int out_size, void* d_ws, size_t ws_size, hipStream_t stream) {
    static int grid_blocks = 0;
    if (grid_blocks == 0) {
        if (n_in != 33 || ws_size < WS_END) { fprintf(stderr, "kernel_launch: n_in %d ws %zu need %zu\n", n_in, ws_size, (size_t)WS_END); grid_blocks = -1; return; }
        if (hipFuncSetAttribute((const void*)mega, hipFuncAttributeMaxDynamicSharedMemorySize, LDS_TOTAL) != hipSuccess) { fprintf(stderr, "hipFuncSetAttribute failed\n"); grid_blocks = -1; return; }
        int dev = 0, cus = 0, per_cu = 0;
        (void)hipGetDevice(&dev); (void)hipDeviceGetAttribute(&cus, hipDeviceAttributeMultiprocessorCount, dev);
        (void)hipOccupancyMaxActiveBlocksPerMultiprocessor(&per_cu, (const void*)mega, NT, LDS_TOTAL);
        if (per_cu < 1) { fprintf(stderr, "occupancy query says %d blocks per CU\n", per_cu); grid_blocks = -1; return; }
        grid_blocks = cus;
    }
    if (grid_blocks < 0) return;
    Params p{};
    const float** pp = (const float**)&p;
    for (int i = 0; i < 33; ++i) pp[i] = (const float*)d_in[i];
    p.out = (float*)d_out; p.ws = (unsigned char*)d_ws;
    (void)hipMemsetAsync((char*)d_ws + WS_CTL, 0, ZERO_BYTES, stream);
    void* args[] = {&p};
    const hipError_t e = hipLaunchCooperativeKernel((const void*)mega, dim3(grid_blocks), dim3(NT), args, LDS_TOTAL, stream);
    if (e != hipSuccess) fprintf(stderr, "launch failed: %s (grid %d)\n", hipGetErrorString(e), grid_blocks);
}
```
